# Optimizing an MI355X kernel written in HIP

```python
import math
import jax, jax.numpy as jnp
from jax import lax
import numpy as np

D_MODEL = 1024
BATCH = 8
SEQ = 8192
DEPTH = 1

ROPE_THETA = 10000.0
EPS = 1e-6
Q_BLOCK = 128

MLA_HEADS = 4
MLA_Q_RANK = 256
MLA_KV_RANK = 256
MLA_NOPE_DIM = 128
MLA_ROPE_DIM = 64
MLA_V_DIM = 128

DIFF_HEADS = 4
DIFF_QK_DIM = 64
DIFF_V_DIM = 2 * DIFF_QK_DIM

MIX_WIDTH = MLA_HEADS * MLA_V_DIM + DIFF_HEADS * DIFF_V_DIM
IN_SPLITS = (MLA_Q_RANK, MLA_KV_RANK, MLA_ROPE_DIM,
             DIFF_HEADS * 2 * DIFF_QK_DIM, DIFF_HEADS * 2 * DIFF_QK_DIM, DIFF_HEADS * DIFF_V_DIM)
IN_COLS = sum(IN_SPLITS)

N_GROUPS = 4
EXPERTS_PER_GROUP = 8
N_EXPERTS = N_GROUPS * EXPERTS_PER_GROUP
TOP_K = 2
D_EXPERT = 512
MOE_BLOCK = 128

kernel_name = 'hymba_mla_diffattn_hiermoe_encoder'


def rms_norm(x, g):
    xf = x.astype(jnp.float32)
    y = xf * lax.rsqrt(jnp.mean(xf * xf, axis=-1, keepdims=True) + EPS)
    return (y * g.astype(jnp.float32)).astype(x.dtype)


def rope(x, pos):
    d = x.shape[-1]
    inv = ROPE_THETA ** (-jnp.arange(0, d, 2, dtype=jnp.float32) / d)
    ang = pos.astype(jnp.float32)[:, None] * inv[None, :]
    shape = (1, x.shape[1]) + (1,) * (x.ndim - 3) + (d // 2,)
    cos = jnp.cos(ang).reshape(shape)
    sin = jnp.sin(ang).reshape(shape)
    xf = x.astype(jnp.float32)
    x1, x2 = xf[..., : d // 2], xf[..., d // 2:]
    return jnp.concatenate([x1 * cos - x2 * sin, x2 * cos + x1 * sin], axis=-1).astype(x.dtype)


def to_blocks(t):
    b, s = t.shape[0], t.shape[1]
    return t.reshape((b, s // Q_BLOCK, Q_BLOCK) + t.shape[2:]).swapaxes(0, 1)


def from_blocks(t):
    nb, b, qb = t.shape[0], t.shape[1], t.shape[2]
    return t.swapaxes(0, 1).reshape((b, nb * qb) + t.shape[3:])


def mla_attention(q_nope, q_pe, k_nope, k_pe, v):
    scale = (q_nope.shape[-1] + q_pe.shape[-1]) ** -0.5

    def block(args):
        qn, qr = args
        s = (jnp.einsum('bqhd,bkhd->bhqk', qn, k_nope)
             + jnp.einsum('bqhr,bkr->bhqk', qr, k_pe)).astype(jnp.float32) * scale
        p = jax.nn.softmax(s, axis=-1).astype(v.dtype)
        return jnp.einsum('bhqk,bkhd->bqhd', p, v)

    return from_blocks(lax.map(block, (to_blocks(q_nope), to_blocks(q_pe))))


def diff_attention(q1, q2, k1, k2, v, lam):
    scale = q1.shape[-1] ** -0.5

    def block(args):
        a1, a2 = args
        s1 = jnp.einsum('bqhd,bkhd->bhqk', a1, k1).astype(jnp.float32) * scale
        s2 = jnp.einsum('bqhd,bkhd->bhqk', a2, k2).astype(jnp.float32) * scale
        p = (jax.nn.softmax(s1, axis=-1) - lam * jax.nn.softmax(s2, axis=-1)).astype(v.dtype)
        return jnp.einsum('bhqk,bkhd->bqhd', p, v)

    return from_blocks(lax.map(block, (to_blocks(q1), to_blocks(q2))))


def hier_moe(h, w_rg, b_rg, w_re, b_re, w_gate, w_up, w_down):
    b, s, d = h.shape
    t = b * s
    a = t * TOP_K
    hf = h.reshape(t, d)
    hf32 = hf.astype(jnp.float32)
    g_logits = hf32 @ w_rg.astype(jnp.float32) + b_rg.astype(jnp.float32)
    g_prob, g_idx = lax.top_k(jax.nn.softmax(g_logits, axis=-1), 1)
    e_logits = (hf32 @ w_re.astype(jnp.float32) + b_re.astype(jnp.float32)).reshape(t, N_GROUPS, EXPERTS_PER_GROUP)
    e_sel = jnp.take_along_axis(e_logits, g_idx[:, :, None], axis=1)[:, 0]
    top_l, top_i = lax.top_k(e_sel, TOP_K)
    weights = (g_prob * jax.nn.softmax(top_l, axis=-1)).astype(h.dtype)
    eid = g_idx * EXPERTS_PER_GROUP + top_i

    e_flat = eid.reshape(a).astype(jnp.int32)
    t_flat = jnp.repeat(jnp.arange(t, dtype=jnp.int32), TOP_K)
    w_flat = weights.reshape(a)
    order = jnp.argsort(e_flat)
    e_s, t_s, w_s = e_flat[order], t_flat[order], w_flat[order]
    counts = jnp.zeros((N_EXPERTS,), jnp.int32).at[e_flat].add(1)
    starts = jnp.cumsum(counts) - counts
    padded = ((counts + MOE_BLOCK - 1) // MOE_BLOCK) * MOE_BLOCK
    pends = jnp.cumsum(padded)
    pstarts = pends - padded
    dest = pstarts[e_s] + (jnp.arange(a, dtype=jnp.int32) - starts[e_s])
    rows = a + N_EXPERTS * MOE_BLOCK
    nb = rows // MOE_BLOCK
    row_token = jnp.zeros((rows,), jnp.int32).at[dest].set(t_s)
    row_weight = jnp.zeros((rows,), h.dtype).at[dest].set(w_s)
    block_expert = jnp.minimum(
        jnp.searchsorted(pends, jnp.arange(nb, dtype=jnp.int32) * MOE_BLOCK, side='right'),
        N_EXPERTS - 1).astype(jnp.int32)
    xs = hf[row_token].reshape(nb, MOE_BLOCK, d)

    def expert_block(args):
        xb, e = args
        g = xb @ w_gate[e]
        u = xb @ w_up[e]
        return (jax.nn.silu(g) * u) @ w_down[e]

    ys = lax.map(expert_block, (xs, block_expert)).reshape(rows, d)
    out = jnp.zeros((t, d), h.dtype).at[row_token].add(ys * row_weight[:, None])
    return out.reshape(b, s, d)


def setup_inputs(seed: int = 0) -> dict:
    key = jax.random.key(seed)
    ks = jax.random.split(key, 32)
    f32 = jnp.float32
    L, D = DEPTH, D_MODEL

    def nrm(k, shape, std):
        return jax.random.normal(k, shape, f32) * std

    def gain(k, shape):
        return 1.0 + 0.02 * jax.random.normal(k, shape, f32)

    return {
        'x': nrm(ks[0], (BATCH, SEQ, D), 1.0),
        'c': nrm(ks[1], (BATCH, D), 1.0),
        'w_ada': nrm(ks[2], (L, D, 6 * D), 0.5 * D ** -0.5),
        'b_ada': nrm(ks[3], (L, 6 * D), 0.02),
        'norm1_g': gain(ks[4], (L, D)),
        'w_in': nrm(ks[5], (L, D, IN_COLS), D ** -0.5),
        'q_a_norm_g': gain(ks[6], (L, MLA_Q_RANK)),
        'w_q_up': nrm(ks[7], (L, MLA_Q_RANK, MLA_HEADS * (MLA_NOPE_DIM + MLA_ROPE_DIM)), MLA_Q_RANK ** -0.5),
        'kv_a_norm_g': gain(ks[8], (L, MLA_KV_RANK)),
        'w_kv_up': nrm(ks[9], (L, MLA_KV_RANK, MLA_HEADS * (MLA_NOPE_DIM + MLA_V_DIM)), MLA_KV_RANK ** -0.5),
        'lambda_q1': nrm(ks[10], (L, DIFF_QK_DIM), 0.1),
        'lambda_k1': nrm(ks[11], (L, DIFF_QK_DIM), 0.1),
        'lambda_q2': nrm(ks[12], (L, DIFF_QK_DIM), 0.1),
        'lambda_k2': nrm(ks[13], (L, DIFF_QK_DIM), 0.1),
        'subln_g': gain(ks[14], (L, DIFF_V_DIM)),
        'w_out': nrm(ks[15], (L, MIX_WIDTH, D), MIX_WIDTH ** -0.5),
        'norm2_g': gain(ks[16], (L, D)),
        'w_router_group': nrm(ks[17], (L, D, N_GROUPS), D ** -0.5),
        'b_router_group': nrm(ks[18], (L, N_GROUPS), 0.01),
        'w_router_expert': nrm(ks[19], (L, D, N_EXPERTS), D ** -0.5),
        'b_router_expert': nrm(ks[20], (L, N_EXPERTS), 0.01),
        'w_expert_gate': nrm(ks[21], (L, N_EXPERTS, D, D_EXPERT), D ** -0.5),
        'w_expert_up': nrm(ks[22], (L, N_EXPERTS, D, D_EXPERT), D ** -0.5),
        'w_expert_down': nrm(ks[23], (L, N_EXPERTS, D_EXPERT, D), D_EXPERT ** -0.5),
        'final_norm_g': gain(ks[24], (D,)),
    }


def reference(x, c, w_ada, b_ada, norm1_g, w_in, q_a_norm_g, w_q_up, kv_a_norm_g, w_kv_up,
              lambda_q1, lambda_k1, lambda_q2, lambda_k2, subln_g, w_out, norm2_g,
              w_router_group, b_router_group, w_router_expert, b_router_expert,
              w_expert_gate, w_expert_up, w_expert_down, final_norm_g):
    b, s, _ = x.shape
    pos = jnp.arange(s, dtype=jnp.int32)
    offsets = [int(v) for v in np.cumsum(IN_SPLITS)[:-1]]
    for l in range(DEPTH):
        mod = jax.nn.silu(c) @ w_ada[l] + b_ada[l]
        shift1, scale1, gate1, shift2, scale2, gate2 = jnp.split(mod, 6, axis=-1)

        h = rms_norm(x, norm1_g[l]) * (1.0 + scale1[:, None, :]) + shift1[:, None, :]
        z = h @ w_in[l]
        c_q, c_kv, k_pe, dq, dk, dv = jnp.split(z, offsets, axis=-1)

        q = (rms_norm(c_q, q_a_norm_g[l]) @ w_q_up[l]).reshape(b, s, MLA_HEADS, MLA_NOPE_DIM + MLA_ROPE_DIM)
        q_nope, q_pe = q[..., :MLA_NOPE_DIM], rope(q[..., MLA_NOPE_DIM:], pos)
        kv = (rms_norm(c_kv, kv_a_norm_g[l]) @ w_kv_up[l]).reshape(b, s, MLA_HEADS, MLA_NOPE_DIM + MLA_V_DIM)
        k_nope, v_mla = kv[..., :MLA_NOPE_DIM], kv[..., MLA_NOPE_DIM:]
        k_pe = rope(k_pe[:, :, None, :], pos)[:, :, 0, :]
        mla_out = mla_attention(q_nope, q_pe, k_nope, k_pe, v_mla).reshape(b, s, MLA_HEADS * MLA_V_DIM)

        dq = rope(dq.reshape(b, s, DIFF_HEADS, 2, DIFF_QK_DIM), pos)
        dk = rope(dk.reshape(b, s, DIFF_HEADS, 2, DIFF_QK_DIM), pos)
        dv = dv.reshape(b, s, DIFF_HEADS, DIFF_V_DIM)
        lambda_init = 0.8 - 0.6 * math.exp(-0.3 * l)
        lam = (jnp.exp(jnp.sum(lambda_q1[l].astype(jnp.float32) * lambda_k1[l].astype(jnp.float32)))
               - jnp.exp(jnp.sum(lambda_q2[l].astype(jnp.float32) * lambda_k2[l].astype(jnp.float32)))
               + lambda_init)
        d_out = diff_attention(dq[..., 0, :], dq[..., 1, :], dk[..., 0, :], dk[..., 1, :], dv, lam)
        d_out = (rms_norm(d_out, subln_g[l]) * (1.0 - lambda_init)).reshape(b, s, DIFF_HEADS * DIFF_V_DIM)

        mix = jnp.concatenate([mla_out, d_out], axis=-1) @ w_out[l]
        x = x + gate1[:, None, :] * mix

        h2 = rms_norm(x, norm2_g[l]) * (1.0 + scale2[:, None, :]) + shift2[:, None, :]
        moe = hier_moe(h2, w_router_group[l], b_router_group[l], w_router_expert[l], b_router_expert[l],
                       w_expert_gate[l], w_expert_up[l], w_expert_down[l])
        x = x + gate2[:, None, :] * moe
    return rms_norm(x, final_norm_g)
```

```cpp
#include <hip/hip_runtime.h>
#include <cstdio>
#include <cstdint>
#ifndef ATT_PRIO
#define ATT_PRIO 0
#endif
#ifndef BAR_DBL
#define BAR_DBL 0
#endif
#ifndef DIFF_DMA_M
#define DIFF_DMA_M false
#endif
#ifndef ATT_SLOTS
#define ATT_SLOTS 1
#endif
#ifndef ATT_SKEW
#define ATT_SKEW 1
#endif
#ifndef ATT_X
#define ATT_X 0
#endif

#define GAS __attribute__((address_space(1)))
#define LAS __attribute__((address_space(3)))
typedef unsigned short bf16_t;
typedef short bf16x8 __attribute__((ext_vector_type(8)));
typedef short s16x4 __attribute__((ext_vector_type(4)));
typedef float f32x2 __attribute__((ext_vector_type(2)));
typedef float f32x4 __attribute__((ext_vector_type(4)));
typedef float f32x16 __attribute__((ext_vector_type(16)));
typedef unsigned u32x2 __attribute__((ext_vector_type(2)));
typedef unsigned u32x4 __attribute__((ext_vector_type(4)));

constexpr int NB = 8, SEQ = 8192, DM = 1024, T_TOK = NB * SEQ;
constexpr int IN_PAD = 2304;
constexpr int NEXP = 32, DEXP = 512, LCAP = 65536;
constexpr float EPS = 1e-6f;
constexpr int NPANEL = T_TOK / 256;
constexpr float QSC_MLA = 0.07216878364870322f * 1.4426950408889634f, QSC_DIFF = 0.125f * 1.4426950408889634f;

constexpr size_t MiB = 1u << 20;
constexpr size_t WS_CTL = 0, CTL_ZERO_BYTES = 1 * MiB;
constexpr size_t WS_MODP = 1 * MiB;
constexpr size_t WS_MOD = 3 * MiB;
constexpr size_t WS_MISC = 3 * MiB + 512 * 1024;
constexpr size_t WS_ROPE = 4 * MiB;
constexpr size_t WS_SSQQ = 6 * MiB, WS_SSQKV = 7 * MiB;
constexpr size_t WS_WIN = 8 * MiB;
constexpr size_t WS_WQ = 13 * MiB;
constexpr size_t WS_WKV = 13 * MiB + 512 * 1024;
constexpr size_t WS_WOUT = 14 * MiB;
constexpr size_t WS_WR = 16 * MiB;
constexpr size_t WS_WGU = 24 * MiB;
constexpr size_t WS_WDN = 88 * MiB;
constexpr size_t WS_LIST = 120 * MiB;
constexpr size_t WS_H = 128 * MiB;
constexpr size_t WS_CQ = 256 * MiB, WS_CKV = 288 * MiB, WS_QA = 320 * MiB, WS_KA = 416 * MiB, WS_VA = 512 * MiB;
constexpr size_t WS_DQ = 576 * MiB, WS_DK = 640 * MiB, WS_DV = 704 * MiB, WS_ATT = 768 * MiB;
constexpr size_t WS_ACT = 256 * MiB;
constexpr size_t WS_Y = 400 * MiB;
constexpr size_t WS_LISTW = 896 * MiB;
constexpr size_t WS_STASH = 904 * MiB;
constexpr size_t WS_END = 936 * MiB;
constexpr int CW_BAR = 4096;
constexpr int CW_ECNT = 16384;

constexpr int LDS_BYTES = 163840;
constexpr int MISC_OFF = LDS_BYTES - 512;

#define RLX_AGENT __ATOMIC_RELAXED, __HIP_MEMORY_SCOPE_AGENT
#define LDS_WAIT() asm volatile("s_waitcnt lgkmcnt(0)" ::: "memory")
#define VM_WAIT() asm volatile("s_waitcnt vmcnt(0)" ::: "memory")
__device__ __forceinline__ unsigned f2bf(float f) { unsigned u = __builtin_bit_cast(unsigned, f); return (u + 0x7fffu + ((u >> 16) & 1u)) >> 16; }
__device__ __forceinline__ unsigned pk2(float lo, float hi) { return f2bf(lo) | (f2bf(hi) << 16); }
__device__ __forceinline__ unsigned cvt_pk_bf16(float lo, float hi) { unsigned r; asm volatile("v_cvt_pk_bf16_f32 %0, %1, %2" : "=v"(r) : "v"(lo), "v"(hi)); return r; }
__device__ __forceinline__ float bf_lo(unsigned w) { return __builtin_bit_cast(float, w << 16); }
__device__ __forceinline__ float bf_hi(unsigned w) { return __builtin_bit_cast(float, w & 0xffff0000u); }
__device__ __forceinline__ int lane_id_v() { int l; asm volatile("v_mbcnt_lo_u32_b32 %0, -1, 0\n\tv_mbcnt_hi_u32_b32 %0, -1, %0" : "=v"(l)); return l; }
__device__ __forceinline__ float wave_sum(float v) {
#pragma unroll
    for (int o = 1; o < 64; o <<= 1) v += __shfl_xor(v, o);
    return v;
}

#define XB_TMO      128
#define XB_XCNT(j)  (256  + 64 * (j))
#define XB_XSUB(j)  (1280 + 64 * (j))
#define XB_XGEN(j)  (2304 + 64 * (j))
#define XB_TOP      3328
#define XB_TOPGEN   3392
#define XCD_BAR_WORDS 3456
#define XB_SPIN_CAP (1u << 18)
__device__ __forceinline__ unsigned xb_ld(unsigned* p)              { return __hip_atomic_load(p, __ATOMIC_RELAXED, __HIP_MEMORY_SCOPE_AGENT); }
__device__ __forceinline__ unsigned xb_add(unsigned* p, unsigned v) { return __hip_atomic_fetch_add(p, v, __ATOMIC_RELAXED, __HIP_MEMORY_SCOPE_AGENT); }
__device__ __forceinline__ unsigned xb_xcc_id() { return (unsigned)__builtin_amdgcn_s_getreg((3 << 11) | 20) & 0xFu; }
#define XB_SPIN(cond, bar) do { unsigned _sp = 0; while (cond) { __builtin_amdgcn_s_sleep(1); \
    if ((++_sp & 255u) == 0u) { if (xb_ld(&(bar)[XB_TMO])) break; if (_sp > XB_SPIN_CAP) { atomicAdd(&(bar)[XB_TMO], 1u); break; } } } } while (0)
struct XcdBarrier { unsigned* bar; unsigned x; volatile LAS unsigned* st; };
__device__ __forceinline__ XcdBarrier xcd_barrier_post(unsigned* bar, volatile LAS unsigned* st, int wave) {
    XcdBarrier b; b.bar = bar; b.x = xb_xcc_id(); b.st = st;
    if (wave == 0 && lane_id_v() == 0) (void)xb_add(&bar[XB_XCNT(b.x)], 1u);
    return b;
}
__device__ __forceinline__ void xcd_barrier_complete(unsigned* bar, unsigned x, unsigned& nloc, unsigned& nx) {
    const unsigned G = gridDim.x * gridDim.y * gridDim.z;
    unsigned sum, cnt, mine, sp = 0u;
    for (;;) {
        sum = 0u; cnt = 0u; mine = 0u;
#pragma unroll
        for (unsigned j = 0; j < 16; ++j) { const unsigned c = xb_ld(&bar[XB_XCNT(j)]); sum += c; cnt += (c > 0u) ? 1u : 0u; mine = (j == x) ? c : mine; }
        if (sum == G) break;
        __builtin_amdgcn_s_sleep(1);
        if ((++sp & 255u) == 0u) { if (xb_ld(&bar[XB_TMO])) break; if (sp > XB_SPIN_CAP) { atomicAdd(&bar[XB_TMO], 1u); break; } }
    }
    nloc = mine > 0u ? mine : 1u; nx = cnt > 0u ? cnt : 1u;
}
__device__ __forceinline__ void xcd_barrier(const XcdBarrier& b, int wave) {
    asm volatile("s_waitcnt vmcnt(0)" ::: "memory");
    __syncthreads();
    if (wave == 0 && lane_id_v() == 0) {
        unsigned* bar = b.bar;
        __builtin_amdgcn_s_waitcnt(0);
        unsigned nloc = b.st[0], nx = b.st[1];
        if (nloc == 0u) { xcd_barrier_complete(bar, b.x, nloc, nx); b.st[0] = nloc; b.st[1] = nx; }
        const unsigned old = xb_add(&bar[XB_XSUB(b.x)], 1u);
        const unsigned gen = old / nloc;
        if (old + 1u == (gen + 1u) * nloc) {
            __builtin_amdgcn_fence(__ATOMIC_RELEASE, "agent");
            asm volatile("s_waitcnt vmcnt(0)" ::: "memory");
            const unsigned og = xb_add(&bar[XB_TOP], 1u);
            const unsigned tg = og / nx;
            if (og + 1u == (tg + 1u) * nx) xb_add(&bar[XB_TOPGEN], 1u);
            else XB_SPIN(xb_ld(&bar[XB_TOPGEN]) == tg, bar);
            __builtin_amdgcn_fence(__ATOMIC_ACQUIRE, "agent");
            xb_add(&bar[XB_XGEN(b.x)], 1u);
            asm volatile("s_waitcnt vmcnt(0)" ::: "memory");
        } else {
            XB_SPIN(xb_ld(&bar[XB_XGEN(b.x)]) == gen, bar);
            __builtin_amdgcn_fence(__ATOMIC_ACQUIRE, "agent");
            asm volatile("s_waitcnt vmcnt(0)" ::: "memory");
        }
    }
    __syncthreads();
}

namespace pg8 {
constexpr int BM = 256, BK = 64, HALF = 128, HTB = HALF * BK * 2, STAGE_BYTES = 8 * HTB, NXCD = 8, WGM = 8;
__host__ __device__ __forceinline__ int lds_byte(int r, int c) { const int st = (r >> 4) * 2 + (c >> 5), rr = r & 15, cc = c & 31, ob = rr * 64 + cc * 2; return st * 1024 + (ob ^ (((ob >> 9) & 1) << 5)); }
__host__ __device__ __forceinline__ void stage_rc(int b, int& R, int& C) { const int st = b / 1024, sb = b % 1024, swz = sb ^ (((sb >> 9) & 1) << 5); R = (st >> 1) * 16 + swz / 64; C = (st & 1) * 32 + (swz % 64) / 2; }
__host__ __device__ __forceinline__ int perm32(int rho) { const int n = rho >> 4, i = rho & 15; return 8 * (i >> 2) + 4 * n + (i & 3); }

struct Unit { int pm, pn, e, t, cnt; };

struct StaticOrder {
    int nM, nN, nwg, G, c;
    __device__ void init(int M, int N, int G_, int c_) { nM = M / BM; nN = N / BM; nwg = nM * nN; G = G_; c = c_; }
    __device__ bool next(int i, Unit& u) const {
        const long L = (long)i * G + c; if (L >= nwg) return false;
        int wgid = (int)L; { const int q = nwg / NXCD, r = nwg % NXCD, xcd = wgid % NXCD, off = wgid / NXCD; wgid = (xcd < r ? xcd * (q + 1) : r * (q + 1) + (xcd - r) * q) + off; }
        const int nig = WGM * nN, gid = wgid / nig, fm = gid * WGM, gsz = (nM - fm) < WGM ? (nM - fm) : WGM;
        u.pm = fm + ((wgid % nig) % gsz); u.pn = (wgid % nig) / gsz; u.e = 0; u.t = u.pm; u.cnt = 0x7fffffff; return true;
    }
    __device__ __forceinline__ int gather(const Unit&, int) const { return 0; }
};
struct MoeOrder {
    const int* list; int endv, cntv, total, G, vcu;
    __device__ void init(const unsigned* ecnt, const int* list_, int G_, int vcu_) {
        list = list_; G = G_; vcu = vcu_;
        const int lane = lane_id_v();
        int c = (lane < NEXP) ? (int)__hip_atomic_load(ecnt + lane, RLX_AGENT) : 0;
        cntv = c; int v = (c + 255) >> 8;
#pragma unroll
        for (int o = 1; o < 64; o <<= 1) { const int t = __shfl_up(v, o); if (lane >= o) v += t; }
        endv = v; total = __builtin_amdgcn_readlane(v, 63);
    }
    __device__ bool next(int i, Unit& u) const {
        const int L = i * G + vcu; const int ti = L >> 2; if (ti >= total) return false;
        const int lane = lane_id_v();
        const unsigned long long m = __ballot(lane < NEXP && endv <= ti);
        const int e = __builtin_amdgcn_readfirstlane(__builtin_popcountll(m));
        const int base = e ? __builtin_amdgcn_readlane(endv, e - 1) : 0;
        u.pm = ti; u.pn = L & 3; u.e = e; u.t = ti - base; u.cnt = __builtin_amdgcn_readlane(cntv, e); return true;
    }
    __device__ __forceinline__ int gather(const Unit& u, int rr) const {
        const int idx = u.t * 256 + rr;
        return idx < u.cnt ? (list[u.e * LCAP + idx] >> 1) : 0;
    }
};

template <class Epi, class Sched, bool GATHER>
__device__ __forceinline__ void gemm_phase(LAS unsigned char* lds, const int wid, const bf16_t* A, int lda, const bf16_t* Bt, int ldb, size_t b_estride, int K, const Sched& S, const Epi& E) {
    const int lane = lane_id_v(), tid = wid * 64 + lane, wr = wid >> 2, wc = wid & 3, fr = lane & 15, fq = lane >> 4;
    const int nt = K / BK;
    unsigned voffA[2], voffB[2]; int RA[2], CA[2];
#pragma unroll
    for (int i = 0; i < 2; ++i) { int R, C; stage_rc(tid * 16 + i * 8192, R, C); const int Rb = Epi::PERM ? ((R & ~31) + perm32(R & 31)) : R;
        RA[i] = R; CA[i] = C; voffA[i] = (unsigned)(R * lda + C) * 2u; voffB[i] = (unsigned)(Rb * ldb + C) * 2u; }
    const size_t kstep = (size_t)(BK * 2);
    const size_t hstepA = (size_t)HALF * lda * 2, hstepB = (size_t)HALF * ldb * 2;
    const size_t tstepA = 2 * hstepA, tstepB = 2 * hstepB;
    const unsigned ldsw = (unsigned)wid * 1024u;
    const int aoff = lds_byte(wr * 64 + fr, fq * 8), boff = lds_byte(wc * 32 + fr, fq * 8);
#define PG8_SA(b, h) (((b) * 2 + (h)) * HTB)
#define PG8_SB(b, h) ((4 + (b) * 2 + (h)) * HTB)
#define PG8_STAGE(bufoff, gbase, voff) do { _Pragma("unroll") for (int _i = 0; _i < 2; ++_i) \
        __builtin_amdgcn_global_load_lds((const unsigned*)((const char*)(gbase) + (voff)[_i]), (LAS unsigned*)(lds + (bufoff) + ldsw + _i * 8192), 16, 0, 0); } while (0)
#define PG8_LDA(dst, b, h) do { _Pragma("unroll") for (int m = 0; m < 4; ++m) _Pragma("unroll") for (int k = 0; k < 2; ++k) dst[m][k] = *(const LAS bf16x8*)(lds + PG8_SA(b, h) + aoff + m * 2048 + k * 1024); } while (0)
#define PG8_LDB(dst, b, h) do { _Pragma("unroll") for (int n = 0; n < 2; ++n) _Pragma("unroll") for (int k = 0; k < 2; ++k) dst[n][k] = *(const LAS bf16x8*)(lds + PG8_SB(b, h) + boff + n * 2048 + k * 1024); } while (0)
#define PG8_MMA(ai, bj, At, Bt_) do { __builtin_amdgcn_s_setprio(1); _Pragma("unroll") for (int m = 0; m < 4; ++m) _Pragma("unroll") for (int n = 0; n < 2; ++n) _Pragma("unroll") for (int k = 0; k < 2; ++k) \
        acc[ai][bj][m][n] = __builtin_amdgcn_mfma_f32_16x16x32_bf16(Bt_[n][k], At[m][k], acc[ai][bj][m][n], 0, 0, 0); __builtin_amdgcn_s_setprio(0); } while (0)
#define PG8_WAIT_V(n) asm volatile("s_waitcnt vmcnt(" #n ")" ::: "memory")
#define PG8_WAIT_L(n) asm volatile("s_waitcnt lgkmcnt(" #n ")" ::: "memory")
#define PG8_BAR __builtin_amdgcn_s_barrier()
#define PG8_SCHED __builtin_amdgcn_sched_barrier(0)
#define PG8_STAGE_A(bufoff, ptr_dense, half, ktoff, goffs) do { if constexpr (GATHER) { PG8_STAGE(bufoff, (const char*)A + (ktoff), goffs); } \
        else { PG8_STAGE(bufoff, (ptr_dense) + (half) * hstepA, voffA); } } while (0)
    Unit cur, nxt; int ui = 0;
    if (!S.next(0, cur)) return;
    f32x4 acc[2][2][4][2];
#pragma unroll
    for (int a = 0; a < 2; ++a)
#pragma unroll
        for (int b = 0; b < 2; ++b)
#pragma unroll
            for (int m = 0; m < 4; ++m)
#pragma unroll
                for (int n = 0; n < 2; ++n) acc[a][b][m][n] = (f32x4){0.f, 0.f, 0.f, 0.f};
    bf16x8 At[4][2], B0[2][2], B1[2][2];
    unsigned gc0[2] = {0u, 0u}, gc1[2] = {0u, 0u}, gn0[2] = {0u, 0u}, gn1[2] = {0u, 0u};
    if constexpr (GATHER) {
#pragma unroll
        for (int i = 0; i < 2; ++i) { gc0[i] = (unsigned)(S.gather(cur, RA[i]) * lda + CA[i]) * 2u; gc1[i] = (unsigned)(S.gather(cur, 128 + RA[i]) * lda + CA[i]) * 2u; }
    }
    const char* cA = (const char*)A + (size_t)cur.pm * tstepA; const char* cB = (const char*)Bt + ((size_t)cur.e * b_estride) * 2 + (size_t)cur.pn * tstepB;
    PG8_STAGE(PG8_SB(0, 0), cB, voffB); PG8_STAGE(PG8_SB(0, 1), cB + hstepB, voffB); PG8_STAGE_A(PG8_SA(0, 0), cA, 0, 0, gc0); PG8_STAGE_A(PG8_SA(0, 1), cA, 1, 0, gc1);
    if (wr == 1) PG8_BAR;
    PG8_WAIT_V(2); PG8_BAR;
    PG8_STAGE(PG8_SB(1, 0), cB + kstep, voffB); PG8_STAGE_A(PG8_SA(1, 0), cA + kstep, 0, kstep, gc0); PG8_STAGE(PG8_SB(1, 1), cB + hstepB + kstep, voffB);
    PG8_WAIT_V(6); PG8_BAR;
    for (;;) {
        const bool has_next = S.next(ui + 1, nxt);
        const char* nA = has_next ? (const char*)A + (size_t)nxt.pm * tstepA : cA;
        const char* nB = has_next ? (const char*)Bt + ((size_t)nxt.e * b_estride) * 2 + (size_t)nxt.pn * tstepB : cB;
        if constexpr (GATHER) {
            if (has_next) {
#pragma unroll
                for (int i = 0; i < 2; ++i) { gn0[i] = (unsigned)(S.gather(nxt, RA[i]) * lda + CA[i]) * 2u; gn1[i] = (unsigned)(S.gather(nxt, 128 + RA[i]) * lda + CA[i]) * 2u; }
            } else {
#pragma unroll
                for (int i = 0; i < 2; ++i) { gn0[i] = gc0[i]; gn1[i] = gc1[i]; }
            }
        }
        for (int t = 0; t < nt; t += 2) {
            const bool last = (t == nt - 2);
            const char* a1 = cA + (size_t)(t + 1) * kstep;
            const char* a2 = last ? nA : cA + (size_t)(t + 2) * kstep; const char* b2 = last ? nB : cB + (size_t)(t + 2) * kstep;
            const char* a3 = a2 + kstep; const char* b3 = b2 + kstep;
            const size_t k1 = (size_t)(t + 1) * kstep, k2 = last ? 0 : (size_t)(t + 2) * kstep, k3 = k2 + kstep;
            unsigned g20[2], g21[2];
#pragma unroll
            for (int i = 0; i < 2; ++i) { g20[i] = last ? gn0[i] : gc0[i]; g21[i] = last ? gn1[i] : gc1[i]; }
            PG8_LDB(B0, 0, 0); PG8_LDB(B1, 0, 1); PG8_SCHED; PG8_LDA(At, 0, 0); PG8_STAGE_A(PG8_SA(1, 1), a1, 1, k1, gc1);
            PG8_WAIT_V(8); PG8_WAIT_L(0); PG8_BAR; PG8_MMA(0, 0, At, B0); PG8_MMA(0, 1, At, B1); PG8_BAR; PG8_SCHED;
            PG8_LDA(At, 0, 1); PG8_STAGE(PG8_SB(0, 0), b2, voffB); PG8_STAGE(PG8_SB(0, 1), b2 + hstepB, voffB); PG8_STAGE_A(PG8_SA(0, 0), a2, 0, k2, g20);
            PG8_WAIT_V(8); PG8_WAIT_L(0); PG8_BAR; PG8_MMA(1, 0, At, B0); PG8_MMA(1, 1, At, B1); PG8_BAR; PG8_SCHED;
            PG8_LDB(B0, 1, 0); PG8_LDB(B1, 1, 1); PG8_SCHED; PG8_LDA(At, 1, 0); PG8_STAGE_A(PG8_SA(0, 1), a2, 1, k2, g21);
            PG8_WAIT_V(8); PG8_WAIT_L(0); PG8_BAR; PG8_MMA(0, 0, At, B0); PG8_MMA(0, 1, At, B1); PG8_BAR; PG8_SCHED;
            PG8_LDA(At, 1, 1); PG8_STAGE(PG8_SB(1, 0), b3, voffB); PG8_STAGE(PG8_SB(1, 1), b3 + hstepB, voffB); PG8_STAGE_A(PG8_SA(1, 0), a3, 0, k3, g20);
            PG8_WAIT_V(8); PG8_WAIT_L(0); PG8_BAR; PG8_MMA(1, 0, At, B0); PG8_MMA(1, 1, At, B1); PG8_BAR; PG8_SCHED;
        }
        if (wr == 0) PG8_BAR;
        E(acc, cur, wr, wc, fr, fq);
        if (!has_next) break;
#pragma unroll
        for (int a = 0; a < 2; ++a)
#pragma unroll
            for (int b = 0; b < 2; ++b)
#pragma unroll
                for (int m = 0; m < 4; ++m)
#pragma unroll
                    for (int n = 0; n < 2; ++n) acc[a][b][m][n] = (f32x4){0.f, 0.f, 0.f, 0.f};
        cur = nxt; cA = nA; cB = nB; ++ui;
        if constexpr (GATHER) {
#pragma unroll
            for (int i = 0; i < 2; ++i) { gc0[i] = gn0[i]; gc1[i] = gn1[i]; }
        }
        if (wr == 1) PG8_BAR;
    }
    PG8_WAIT_V(0);
    PG8_BAR;
#undef PG8_SA
#undef PG8_SB
#undef PG8_STAGE
#undef PG8_STAGE_A
#undef PG8_LDA
#undef PG8_LDB
#undef PG8_MMA
#undef PG8_WAIT_V
#undef PG8_WAIT_L
#undef PG8_BAR
#undef PG8_SCHED
}

typedef const f32x4 (&AccT)[2][2][4][2];
__device__ __forceinline__ u32x4 pack8(f32x4 v0, f32x4 v1) { u32x4 w; w.x = cvt_pk_bf16(v0[0], v0[1]); w.y = cvt_pk_bf16(v0[2], v0[3]); w.z = cvt_pk_bf16(v1[0], v1[1]); w.w = cvt_pk_bf16(v1[2], v1[3]); return w; }
__device__ __forceinline__ void rope8(f32x4& v0, f32x4& v1, f32x4 t0, f32x4 t1) {
    f32x4 a, b;
    a[0] = v0[0] * t0[0] - v0[1] * t0[1]; a[1] = v0[1] * t0[0] + v0[0] * t0[1]; a[2] = v0[2] * t0[2] - v0[3] * t0[3]; a[3] = v0[3] * t0[2] + v0[2] * t0[3];
    b[0] = v1[0] * t1[0] - v1[1] * t1[1]; b[1] = v1[1] * t1[0] + v1[0] * t1[1]; b[2] = v1[2] * t1[2] - v1[3] * t1[3]; b[3] = v1[3] * t1[2] + v1[2] * t1[3];
    v0 = a; v1 = b;
}
struct EpiG1 {
    static constexpr bool PERM = true;
    bf16_t *CQ, *CKV, *DQ, *DK, *DV, *KA; float *SSQQ, *SSQKV; const float* rope;
    __device__ __forceinline__ void operator()(AccT acc, const Unit& u, int wr, int wc, int, int) const {
        const int lane_ = lane_id_v(), fr = lane_ & 15, fq = lane_ >> 4;
        const int row0 = u.pm * BM + wr * 64 + fr, cw = wc * 32 + 8 * fq, pn = u.pn;
        if (pn <= 1) {
            bf16_t* dst = pn ? CKV : CQ; float* ssq = pn ? SSQKV : SSQQ;
#pragma unroll
            for (int ai = 0; ai < 2; ++ai)
#pragma unroll
                for (int m = 0; m < 4; ++m) { const int r = row0 + ai * HALF + m * 16; float s = 0.f;
#pragma unroll
                    for (int bj = 0; bj < 2; ++bj) { const f32x4 v0 = acc[ai][bj][m][0], v1 = acc[ai][bj][m][1];
                        s += (v0[0] * v0[0] + v0[1] * v0[1]) + (v0[2] * v0[2] + v0[3] * v0[3]) + (v1[0] * v1[0] + v1[1] * v1[1]) + (v1[2] * v1[2] + v1[3] * v1[3]);
                        *(u32x4*)(dst + (size_t)r * 256 + bj * HALF + cw) = pack8(v0, v1); }
                    s += __shfl_xor(s, 16); s += __shfl_xor(s, 32);
                    if (fq == 0) ssq[(size_t)r * 4 + wc] = s; }
        } else if (pn <= 5) {
            bf16_t* dst = (pn <= 3) ? DQ : DK; const int cbase = ((pn - 2) & 1) * 256; const int p0 = 16 * (wc & 1) + 4 * fq; const float qs = (pn <= 3) ? QSC_DIFF : 1.0f;
#pragma unroll
            for (int ai = 0; ai < 2; ++ai)
#pragma unroll
                for (int m = 0; m < 4; ++m) { const int r = row0 + ai * HALF + m * 16; const int pos = r & (SEQ - 1);
                    const f32x4 t0 = *(const f32x4*)(rope + ((size_t)pos * 32 + p0) * 2), t1 = *(const f32x4*)(rope + ((size_t)pos * 32 + p0 + 2) * 2);
#pragma unroll
                    for (int bj = 0; bj < 2; ++bj) { f32x4 v0 = acc[ai][bj][m][0] * qs, v1 = acc[ai][bj][m][1] * qs; rope8(v0, v1, t0, t1);
                        *(u32x4*)(dst + (size_t)r * 512 + cbase + bj * HALF + cw) = pack8(v0, v1); } }
        } else if (pn <= 7) {
#pragma unroll
            for (int ai = 0; ai < 2; ++ai)
#pragma unroll
                for (int m = 0; m < 4; ++m) { const int r = row0 + ai * HALF + m * 16;
#pragma unroll
                    for (int bj = 0; bj < 2; ++bj) *(u32x4*)(DV + (size_t)r * 512 + (pn - 6) * 256 + bj * HALF + cw) = pack8(acc[ai][bj][m][0], acc[ai][bj][m][1]); }
        } else {
            if (wc < 2) { const int p0 = 16 * wc + 4 * fq;
#pragma unroll
                for (int ai = 0; ai < 2; ++ai)
#pragma unroll
                    for (int m = 0; m < 4; ++m) { const int r = row0 + ai * HALF + m * 16; const int pos = r & (SEQ - 1);
                        const f32x4 t0 = *(const f32x4*)(rope + ((size_t)pos * 32 + p0) * 2), t1 = *(const f32x4*)(rope + ((size_t)pos * 32 + p0 + 2) * 2);
                        f32x4 v0 = acc[ai][0][m][0], v1 = acc[ai][0][m][1]; rope8(v0, v1, t0, t1); const u32x4 w = pack8(v0, v1);
#pragma unroll
                        for (int h = 0; h < 4; ++h) *(u32x4*)(KA + (size_t)r * 768 + h * 192 + 128 + cw) = w; } }
        }
    }
};
struct EpiQ {
    static constexpr bool PERM = true;
    bf16_t* QA; const float* SSQQ; const float* rope;
    __device__ __forceinline__ void operator()(AccT acc, const Unit& u, int wr, int wc, int, int) const {
        const int lane_ = lane_id_v(), fr = lane_ & 15, fq = lane_ >> 4;
        const int row0 = u.pm * BM + wr * 64 + fr;
#pragma unroll
        for (int ai = 0; ai < 2; ++ai)
#pragma unroll
            for (int m = 0; m < 4; ++m) { const int r = row0 + ai * HALF + m * 16; const int pos = r & (SEQ - 1);
                const f32x4 ss = *(const f32x4*)(SSQQ + (size_t)r * 4); const float rstd = 1.0f / sqrtf(((ss[0] + ss[1]) + (ss[2] + ss[3])) * (1.0f / 256.0f) + EPS);
#pragma unroll
                for (int bj = 0; bj < 2; ++bj) { const int colt = u.pn * BM + bj * HALF + wc * 32; const int w = colt % 192; const int col = colt + 8 * fq;
                    f32x4 v0 = acc[ai][bj][m][0] * (rstd * QSC_MLA), v1 = acc[ai][bj][m][1] * (rstd * QSC_MLA);
                    if (w >= 128) { const int p0 = (w - 128 + 8 * fq) >> 1;
                        const f32x4 t0 = *(const f32x4*)(rope + ((size_t)pos * 32 + p0) * 2), t1 = *(const f32x4*)(rope + ((size_t)pos * 32 + p0 + 2) * 2); rope8(v0, v1, t0, t1); }
                    *(u32x4*)(QA + (size_t)r * 768 + col) = pack8(v0, v1); } }
    }
};
struct EpiKV {
    static constexpr bool PERM = true;
    bf16_t *KA, *VA; const float* SSQKV;
    __device__ __forceinline__ void operator()(AccT acc, const Unit& u, int wr, int wc, int, int) const {
        const int lane_ = lane_id_v(), fr = lane_ & 15, fq = lane_ >> 4;
        const int row0 = u.pm * BM + wr * 64 + fr, cw = wc * 32 + 8 * fq, h = u.pn;
#pragma unroll
        for (int ai = 0; ai < 2; ++ai)
#pragma unroll
            for (int m = 0; m < 4; ++m) { const int r = row0 + ai * HALF + m * 16;
                const f32x4 ss = *(const f32x4*)(SSQKV + (size_t)r * 4); const float rstd = 1.0f / sqrtf(((ss[0] + ss[1]) + (ss[2] + ss[3])) * (1.0f / 256.0f) + EPS);
                *(u32x4*)(KA + (size_t)r * 768 + h * 192 + cw) = pack8(acc[ai][0][m][0] * rstd, acc[ai][0][m][1] * rstd);
                *(u32x4*)(VA + (size_t)r * 512 + h * 128 + cw) = pack8(acc[ai][1][m][0] * rstd, acc[ai][1][m][1] * rstd); }
    }
};
struct EpiX1 {
    static constexpr bool PERM = false;
    const float* x; float* x1; const float* mod;
    __device__ __forceinline__ void operator()(AccT acc, const Unit& u, int wr, int wc, int, int) const {
        const int lane_ = lane_id_v(), fr = lane_ & 15, fq = lane_ >> 4;
        const int row0 = u.pm * BM + wr * 64 + fr, col0 = u.pn * BM + wc * 32 + 4 * fq, b = u.pm >> 5;
        f32x4 g[2][2];
#pragma unroll
        for (int bj = 0; bj < 2; ++bj)
#pragma unroll
            for (int n = 0; n < 2; ++n) g[bj][n] = *(const f32x4*)(mod + (size_t)(b * 6 + 2) * DM + col0 + bj * HALF + n * 16);
#pragma unroll
        for (int ai = 0; ai < 2; ++ai)
#pragma unroll
            for (int m = 0; m < 4; ++m) { const size_t off = (size_t)(row0 + ai * HALF + m * 16) * DM + col0;
#pragma unroll
                for (int bj = 0; bj < 2; ++bj)
#pragma unroll
                    for (int n = 0; n < 2; ++n) { const f32x4 xv = *(const f32x4*)(x + off + bj * HALF + n * 16); *(f32x4*)(x1 + off + bj * HALF + n * 16) = xv + g[bj][n] * acc[ai][bj][m][n]; } }
    }
};
__device__ __forceinline__ float silu_mul(float g, float u) { return g * u * __builtin_amdgcn_rcpf(1.0f + __builtin_amdgcn_exp2f(-1.4426950408889634f * g)); }
struct EpiAct {
    static constexpr bool PERM = true;
    bf16_t* ACT;
    __device__ __forceinline__ void operator()(AccT acc, const Unit& u, int wr, int wc, int, int) const {
        const int lane_ = lane_id_v(), fr = lane_ & 15, fq = lane_ >> 4;
        const int row0 = u.pm * BM + wr * 64 + fr, col = u.pn * 128 + wc * 32 + 8 * fq;
#pragma unroll
        for (int ai = 0; ai < 2; ++ai)
#pragma unroll
            for (int m = 0; m < 4; ++m) { const int r = row0 + ai * HALF + m * 16; f32x4 a0, a1;
#pragma unroll
                for (int q = 0; q < 4; ++q) { a0[q] = silu_mul(acc[ai][0][m][0][q], acc[ai][1][m][0][q]); a1[q] = silu_mul(acc[ai][0][m][1][q], acc[ai][1][m][1][q]); }
                *(u32x4*)(ACT + (size_t)r * DEXP + col) = pack8(a0, a1); }
    }
};
struct EpiDown {
    static constexpr bool PERM = true;
    bf16_t* Y; const int* list; const float* listw;
    __device__ __forceinline__ void operator()(AccT acc, const Unit& u, int wr, int wc, int, int) const {
        const int lane_ = lane_id_v(), fr = lane_ & 15, fq = lane_ >> 4;
        const int cw = u.pn * BM + wc * 32 + 8 * fq;
#pragma unroll
        for (int ai = 0; ai < 2; ++ai)
#pragma unroll
            for (int m = 0; m < 4; ++m) { const int idx = u.t * 256 + ai * HALF + wr * 64 + m * 16 + fr;
                if (idx < u.cnt) { const int ent = list[u.e * LCAP + idx]; const float w = listw[u.e * LCAP + idx];
#pragma unroll
                    for (int bj = 0; bj < 2; ++bj) *(u32x4*)(Y + (size_t)ent * DM + cw + bj * HALF) = pack8(acc[ai][bj][m][0] * w, acc[ai][bj][m][1] * w); } }
    }
};
}

namespace att {
constexpr int NW = 8, QBLK = 32, KVBLK = 64, DV = 128;
constexpr float THR = 8.f;
#define SBAR() __builtin_amdgcn_sched_barrier(0)
__device__ __forceinline__ int crow(int r, int hi) { return (r & 3) + 8 * (r >> 2) + 4 * hi; }
__device__ __forceinline__ unsigned cvtpk(float lo, float hi) { unsigned r; asm volatile("v_cvt_pk_bf16_f32 %0, %1, %2" : "=v"(r) : "v"(lo), "v"(hi)); return r; }
__device__ __forceinline__ int kg(int row) { return (row >> 1) & 7; }
template <int DQK> __device__ __forceinline__ int kswz(int row, int colB) { return row * (DQK * 2) + (colB ^ (kg(row) << 4)); }
template <int DQK> struct Sc { static constexpr float SCALE = (DQK == 192) ? 0.07216878364870322f : 0.125f; };

__device__ __forceinline__ int v_st(int k, int c) { const int kk = (k & ~0xC) | ((k & 4) << 1) | ((k & 8) >> 1); return ((kk >> 3) * 4 + (c >> 5)) * 512 + ((kk & 7) * 32 + (c & 31)) * 2; }
__device__ __forceinline__ int v_rd_base(int lane) { return ((lane & 3) << 3) | (((lane >> 2) & 3) << 6) | (((lane >> 4) & 1) << 5) | (((lane >> 5) & 1) << 8); }
constexpr int v_rd_off(int d0, int ks, int half) { return d0 * 512 + ks * 4096 + half * 2048; }
__device__ __forceinline__ void glds16(const void* gsrc, LAS unsigned* dst) { __builtin_amdgcn_global_load_lds((const unsigned*)gsrc, dst, 16, 0, 0); }
template <int OFF> __device__ __forceinline__ void dsr128(bf16x8& d, int addr) { asm volatile("ds_read_b128 %0, %1 offset:%2" : "=v"(d) : "v"(addr), "i"(OFF)); }
template <int OFF> __device__ __forceinline__ void dstr64(s16x4& d, int addr) { asm volatile("ds_read_b64_tr_b16 %0, %1 offset:%2" : "=v"(d) : "v"(addr), "i"(OFF)); }
#define LW2(N, a, b) asm volatile("s_waitcnt lgkmcnt(" #N ")" : "+v"(a), "+v"(b))
#define LW8(N, a) asm volatile("s_waitcnt lgkmcnt(" #N ")" : "+v"(a[0]), "+v"(a[1]), "+v"(a[2]), "+v"(a[3]), "+v"(a[4]), "+v"(a[5]), "+v"(a[6]), "+v"(a[7]))
#define BAR_ALL() asm volatile("s_waitcnt lgkmcnt(0)\n\ts_barrier" ::: "memory")


constexpr float THRL = 8.f;
__device__ __forceinline__ void smax_tile(f32x16& p0, f32x16& p1, float& mhat, float& l_reg, f32x16 (&o)[4], float* al_l, const bool first, int r32, int hi,
                                          bf16x8& pa0, bf16x8& pa1, bf16x8& pa2, bf16x8& pa3) {
    float a = fmaxf(fmaxf(p0[0], p0[1]), p1[0]), b = fmaxf(fmaxf(p0[2], p0[3]), p1[1]); a = fmaxf(fmaxf(a, p1[2]), p1[3]);
#pragma unroll
    for (int r = 4; r < 16; r += 4) { a = fmaxf(fmaxf(a, p0[r]), p0[r + 1]); b = fmaxf(fmaxf(b, p0[r + 2]), p0[r + 3]); a = fmaxf(fmaxf(a, p1[r]), p1[r + 1]); b = fmaxf(fmaxf(b, p1[r + 2]), p1[r + 3]); }
    float rm = fmaxf(a, b);
    { auto rr = __builtin_amdgcn_permlane32_swap(__float_as_uint(rm), __float_as_uint(rm), false, false); rm = fmaxf(__uint_as_float(rr[0]), __uint_as_float(rr[1])); }
    if (__builtin_expect(first || __any(rm > THRL), 0)) {
        const float dl = first ? rm : fmaxf(rm, 0.f);
        mhat += dl;
#pragma unroll
        for (int r = 0; r < 16; ++r) { p0[r] -= dl; p1[r] -= dl; }
        if (!first) { const float f = __builtin_amdgcn_exp2f(-dl); l_reg *= f;
            if (hi == 0) al_l[r32] = f; asm volatile("s_waitcnt lgkmcnt(0)" ::: "memory");
#pragma unroll
            for (int d = 0; d < 4; ++d)
#pragma unroll
                for (int r = 0; r < 16; ++r) o[d][r] *= al_l[crow(r, hi)]; }
    }
#pragma unroll
    for (int r = 0; r < 16; ++r) p0[r] = __builtin_amdgcn_exp2f(p0[r]);
#pragma unroll
    for (int r = 0; r < 16; ++r) p1[r] = __builtin_amdgcn_exp2f(p1[r]);
    float ps = 0;
#pragma unroll
    for (int r = 0; r < 16; ++r) ps += p0[r];
#pragma unroll
    for (int r = 0; r < 16; ++r) ps += p1[r];
    { auto rr = __builtin_amdgcn_permlane32_swap(__float_as_uint(ps), __float_as_uint(ps), false, false); ps = __uint_as_float(rr[0]) + __uint_as_float(rr[1]); }
    l_reg += ps;
#define PK4(P, BASE, OUT) do { u32x4 w = {cvtpk(P[BASE + 0], P[BASE + 1]), cvtpk(P[BASE + 2], P[BASE + 3]), cvtpk(P[BASE + 4], P[BASE + 5]), cvtpk(P[BASE + 6], P[BASE + 7])}; \
    OUT = *reinterpret_cast<bf16x8*>(&w); } while (0)
    PK4(p0, 0, pa0); PK4(p0, 8, pa1); PK4(p1, 0, pa2); PK4(p1, 8, pa3);
#undef PK4
}
template <int DQK, int D, int XP = 0> __device__ __forceinline__ void krd(bf16x8& f0, bf16x8& f1, const int (&ka_)[4]) {
    if constexpr (XP & 8) { asm volatile("" : "=v"(f0), "=v"(f1)); } else {
    dsr128<(D >> 2) * 128>(f0, ka_[D & 3]); dsr128<(D >> 2) * 128 + 32 * DQK * 2>(f1, ka_[D & 3]); } }
template <int KS, int XP = 0> __device__ __forceinline__ void vrd(s16x4 (&v)[8], int vb_) {
    if constexpr (XP & 8) { asm volatile("" : "=v"(v[0]), "=v"(v[1]), "=v"(v[2]), "=v"(v[3]), "=v"(v[4]), "=v"(v[5]), "=v"(v[6]), "=v"(v[7])); return; }
    dstr64<v_rd_off(0, KS, 0)>(v[0], vb_); dstr64<v_rd_off(0, KS, 1)>(v[1], vb_); dstr64<v_rd_off(1, KS, 0)>(v[2], vb_); dstr64<v_rd_off(1, KS, 1)>(v[3], vb_);
    dstr64<v_rd_off(2, KS, 0)>(v[4], vb_); dstr64<v_rd_off(2, KS, 1)>(v[5], vb_); dstr64<v_rd_off(3, KS, 0)>(v[6], vb_); dstr64<v_rd_off(3, KS, 1)>(v[7], vb_); }
#define PKV(L, H) (bf16x8){L[0], L[1], L[2], L[3], H[0], H[1], H[2], H[3]}
__device__ __forceinline__ void pvmma(f32x16 (&o)[4], const s16x4 (&v)[8], bf16x8 pa) {
    o[0] = __builtin_amdgcn_mfma_f32_32x32x16_bf16(pa, PKV(v[0], v[1]), o[0], 0, 0, 0); o[1] = __builtin_amdgcn_mfma_f32_32x32x16_bf16(pa, PKV(v[2], v[3]), o[1], 0, 0, 0);
    o[2] = __builtin_amdgcn_mfma_f32_32x32x16_bf16(pa, PKV(v[4], v[5]), o[2], 0, 0, 0); o[3] = __builtin_amdgcn_mfma_f32_32x32x16_bf16(pa, PKV(v[6], v[7]), o[3], 0, 0, 0); }
#undef PKV
template <int DQK, bool HASPV, int D0, int XP = 0>
__device__ __forceinline__ void qk_step(bf16x8 (&kf)[DQK / 16][2], s16x4 (&vf0)[8], const int (&ka_)[4], int vb_, const bf16x8* qr, f32x16& p0, f32x16& p1, const float nm) {
    constexpr int NQ = DQK / 16;
    if constexpr (D0 + 2 < NQ) krd<DQK, D0 + 2, XP>(kf[D0 + 2][0], kf[D0 + 2][1], ka_);
    if constexpr (HASPV && D0 == NQ - 2) vrd<0, XP>(vf0, vb_);
    if constexpr (D0 + 2 < NQ) LW2(4, kf[D0][0], kf[D0][1]);
    else if constexpr (D0 == NQ - 2) { if constexpr (HASPV) LW2(10, kf[D0][0], kf[D0][1]); else LW2(2, kf[D0][0], kf[D0][1]); }
    else { if constexpr (HASPV) LW2(8, kf[D0][0], kf[D0][1]); else LW2(0, kf[D0][0], kf[D0][1]); }
    SBAR();
    if constexpr (D0 == 0) { f32x16 negm;
#pragma unroll
        for (int r = 0; r < 16; ++r) negm[r] = nm;
        p0 = __builtin_amdgcn_mfma_f32_32x32x16_bf16(kf[D0][0], qr[D0], negm, 0, 0, 0); p1 = __builtin_amdgcn_mfma_f32_32x32x16_bf16(kf[D0][1], qr[D0], negm, 0, 0, 0); }
    else { p0 = __builtin_amdgcn_mfma_f32_32x32x16_bf16(kf[D0][0], qr[D0], p0, 0, 0, 0); p1 = __builtin_amdgcn_mfma_f32_32x32x16_bf16(kf[D0][1], qr[D0], p1, 0, 0, 0); }
    SBAR();
    if constexpr (D0 + 1 < NQ) qk_step<DQK, HASPV, D0 + 1, XP>(kf, vf0, ka_, vb_, qr, p0, p1, nm);
}
template <int DQK, bool HASQK, bool HASPV, int XP = 0>
__device__ __forceinline__ void seg_m(const int (&ka_)[4], int vb_, const bf16x8* qr, f32x16& p0, f32x16& p1, const float nm, f32x16 (&o)[4], bf16x8 pa0, bf16x8 pa1, bf16x8 pa2, bf16x8 pa3) {
    constexpr int NQ = DQK / 16;
    bf16x8 kf[NQ][2]; s16x4 vf[4][8];
    if constexpr (HASQK) { krd<DQK, 0, XP>(kf[0][0], kf[0][1], ka_); krd<DQK, 1, XP>(kf[1][0], kf[1][1], ka_);
        qk_step<DQK, HASPV, 0, XP>(kf, vf[0], ka_, vb_, qr, p0, p1, nm); }
    else if constexpr (HASPV) vrd<0, XP>(vf[0], vb_);
    if constexpr (HASPV) {
        vrd<1, XP>(vf[1], vb_); LW8(8, vf[0]); SBAR(); pvmma(o, vf[0], pa0); SBAR();
        vrd<2, XP>(vf[2], vb_); LW8(8, vf[1]); SBAR(); pvmma(o, vf[1], pa1); SBAR();
        vrd<3, XP>(vf[3], vb_); LW8(8, vf[2]); SBAR(); pvmma(o, vf[2], pa2); SBAR();
        LW8(0, vf[3]); SBAR(); pvmma(o, vf[3], pa3); SBAR(); }
}

#define LW1(N, a) asm volatile("s_waitcnt lgkmcnt(" #N ")" : "+v"(a))
template <int DQK, bool HASQK, bool HASPV, int J>
__device__ __forceinline__ void slot_read(bf16x8 (&kf)[DQK / 16][2], s16x4 (&vf)[4][8], const int (&ka_)[4], int vb_) {
    constexpr int NQS = HASQK ? 2 * (DQK / 16) : 0, NS = NQS + (HASPV ? 16 : 0);
    if constexpr (J < NQS) { constexpr int d0 = J >> 1, h = J & 1; dsr128<(d0 >> 2) * 128 + h * 32 * DQK * 2>(kf[d0][h], ka_[d0 & 3]); }
    else if constexpr (J < NS) { constexpr int q = J - NQS, g = q >> 2, d = q & 3; dstr64<v_rd_off(d, g, 0)>(vf[g][2 * d], vb_); dstr64<v_rd_off(d, g, 1)>(vf[g][2 * d + 1], vb_); }
}
template <int DQK, bool HASQK, bool HASPV, int J>
__device__ __forceinline__ void slot_run(bf16x8 (&kf)[DQK / 16][2], s16x4 (&vf)[4][8], const int (&ka_)[4], int vb_, const bf16x8* qr, f32x16& p0, f32x16& p1, const f32x16& negm,
                                         f32x16 (&o)[4], const bf16x8 (&pa)[4]) {
    constexpr int NQS = HASQK ? 2 * (DQK / 16) : 0, NS = NQS + (HASPV ? 16 : 0);
    if constexpr (J < NS) {
        constexpr int rd1 = (J + 1 < NS) ? ((J + 1 < NQS) ? 1 : 2) : 0, rd2 = (J + 2 < NS) ? ((J + 2 < NQS) ? 1 : 2) : 0, rd3 = (J + 3 < NS) ? ((J + 3 < NQS) ? 1 : 2) : 0, NW = rd1 + rd2 + rd3;
#define LWN1(a) do { if constexpr (NW == 0) LW1(0, a); else if constexpr (NW == 1) LW1(1, a); else if constexpr (NW == 2) LW1(2, a); else if constexpr (NW == 3) LW1(3, a); else if constexpr (NW == 4) LW1(4, a); else if constexpr (NW == 5) LW1(5, a); else LW1(6, a); } while (0)
#define LWN2(a, b) do { if constexpr (NW == 0) LW2(0, a, b); else if constexpr (NW == 1) LW2(1, a, b); else if constexpr (NW == 2) LW2(2, a, b); else if constexpr (NW == 3) LW2(3, a, b); else if constexpr (NW == 4) LW2(4, a, b); else if constexpr (NW == 5) LW2(5, a, b); else LW2(6, a, b); } while (0)
        if constexpr (J < NQS) { constexpr int d0 = J >> 1, h = J & 1;
            LWN1(kf[d0][h]); SBAR();
            if constexpr (h == 0) p0 = __builtin_amdgcn_mfma_f32_32x32x16_bf16(kf[d0][0], qr[d0], (d0 == 0) ? negm : p0, 0, 0, 0);
            else p1 = __builtin_amdgcn_mfma_f32_32x32x16_bf16(kf[d0][1], qr[d0], (d0 == 0) ? negm : p1, 0, 0, 0);
        } else { constexpr int q = J - NQS, g = q >> 2, d = q & 3;
            LWN2(vf[g][2 * d], vf[g][2 * d + 1]); SBAR();
            o[d] = __builtin_amdgcn_mfma_f32_32x32x16_bf16(pa[g], (bf16x8){vf[g][2 * d][0], vf[g][2 * d][1], vf[g][2 * d][2], vf[g][2 * d][3], vf[g][2 * d + 1][0], vf[g][2 * d + 1][1], vf[g][2 * d + 1][2], vf[g][2 * d + 1][3]}, o[d], 0, 0, 0);
        }
#undef LWN1
#undef LWN2
        SBAR();
        slot_read<DQK, HASQK, HASPV, J + 4>(kf, vf, ka_, vb_);
        SBAR();
        slot_run<DQK, HASQK, HASPV, J + 1>(kf, vf, ka_, vb_, qr, p0, p1, negm, o, pa);
    }
}
#define LW3(N, a, b, c) asm volatile("s_waitcnt lgkmcnt(" #N ")" : "+v"(a), "+v"(b), "+v"(c))
#define LW4(N, a, b, c, d) asm volatile("s_waitcnt lgkmcnt(" #N ")" : "+v"(a), "+v"(b), "+v"(c), "+v"(d))
template <int DQK, bool HASQK, bool HASPV, int J>
__device__ __forceinline__ void slot_mma(bf16x8 (&kf)[DQK / 16][2], s16x4 (&vf)[4][8], const bf16x8* qr, f32x16& p0, f32x16& p1, const f32x16& negm, f32x16 (&o)[4], const bf16x8 (&pa)[4]) {
    constexpr int NQS = HASQK ? 2 * (DQK / 16) : 0;
    if constexpr (J < NQS) { constexpr int d0 = J >> 1, h = J & 1;
        if constexpr (h == 0) p0 = __builtin_amdgcn_mfma_f32_32x32x16_bf16(kf[d0][0], qr[d0], (d0 == 0) ? negm : p0, 0, 0, 0);
        else p1 = __builtin_amdgcn_mfma_f32_32x32x16_bf16(kf[d0][1], qr[d0], (d0 == 0) ? negm : p1, 0, 0, 0);
    } else { constexpr int q = J - NQS, g = q >> 2, d = q & 3;
        o[d] = __builtin_amdgcn_mfma_f32_32x32x16_bf16(pa[g], (bf16x8){vf[g][2 * d][0], vf[g][2 * d][1], vf[g][2 * d][2], vf[g][2 * d][3], vf[g][2 * d + 1][0], vf[g][2 * d + 1][1], vf[g][2 * d + 1][2], vf[g][2 * d + 1][3]}, o[d], 0, 0, 0); }
}
template <int DQK, bool HASQK, bool HASPV, int J>
__device__ __forceinline__ void slot_run2(bf16x8 (&kf)[DQK / 16][2], s16x4 (&vf)[4][8], const int (&ka_)[4], int vb_, const bf16x8* qr, f32x16& p0, f32x16& p1, const f32x16& negm,
                                          f32x16 (&o)[4], const bf16x8 (&pa)[4]) {
    constexpr int NQS = HASQK ? 2 * (DQK / 16) : 0, NS = NQS + (HASPV ? 16 : 0);
    if constexpr (J < NS) {
        constexpr int rd2 = (J + 2 < NS) ? ((J + 2 < NQS) ? 1 : 2) : 0, rd3 = (J + 3 < NS) ? ((J + 3 < NQS) ? 1 : 2) : 0, NW = rd2 + rd3;
#define WCASE(MAC, ...) do { if constexpr (NW == 0) MAC(0, __VA_ARGS__); else if constexpr (NW == 1) MAC(1, __VA_ARGS__); else if constexpr (NW == 2) MAC(2, __VA_ARGS__); else if constexpr (NW == 3) MAC(3, __VA_ARGS__); else MAC(4, __VA_ARGS__); } while (0)
        if constexpr (J + 1 < NQS) { WCASE(LW2, kf[J >> 1][0], kf[J >> 1][1]); }
        else if constexpr (J >= NQS) { constexpr int q = J - NQS, g = q >> 2, d = q & 3; WCASE(LW4, vf[g][2 * d], vf[g][2 * d + 1], vf[g][2 * d + 2], vf[g][2 * d + 3]); }
#undef WCASE
        SBAR();
        slot_mma<DQK, HASQK, HASPV, J>(kf, vf, qr, p0, p1, negm, o, pa); SBAR();
        slot_read<DQK, HASQK, HASPV, J + 4>(kf, vf, ka_, vb_); SBAR();
        slot_mma<DQK, HASQK, HASPV, J + 1>(kf, vf, qr, p0, p1, negm, o, pa); SBAR();
        slot_read<DQK, HASQK, HASPV, J + 5>(kf, vf, ka_, vb_); SBAR();
        slot_run2<DQK, HASQK, HASPV, J + 2>(kf, vf, ka_, vb_, qr, p0, p1, negm, o, pa);
    }
}
template <int DQK, bool HASQK, bool HASPV>
__device__ __forceinline__ void seg_m2(const int (&ka_)[4], int vb_, const bf16x8* qr, f32x16& p0, f32x16& p1, const float nm, f32x16 (&o)[4], bf16x8 pa0, bf16x8 pa1, bf16x8 pa2, bf16x8 pa3) {
    bf16x8 kf[DQK / 16][2]; s16x4 vf[4][8]; const bf16x8 pa[4] = {pa0, pa1, pa2, pa3};
    slot_read<DQK, HASQK, HASPV, 0>(kf, vf, ka_, vb_); slot_read<DQK, HASQK, HASPV, 1>(kf, vf, ka_, vb_); slot_read<DQK, HASQK, HASPV, 2>(kf, vf, ka_, vb_); slot_read<DQK, HASQK, HASPV, 3>(kf, vf, ka_, vb_);
    SBAR();
    f32x16 negm;
#pragma unroll
    for (int r = 0; r < 16; ++r) negm[r] = nm;
    asm volatile("" : "+v"(negm));
    SBAR();
    if constexpr (ATT_SLOTS == 2) slot_run2<DQK, HASQK, HASPV, 0>(kf, vf, ka_, vb_, qr, p0, p1, negm, o, pa);
    else slot_run<DQK, HASQK, HASPV, 0>(kf, vf, ka_, vb_, qr, p0, p1, negm, o, pa);
}
#undef LW1
#undef LW3
#undef LW4
template <int DQK, int LDQ, int LDK, int LDV, int XP = 0, bool DMA_M = false>
__device__ __forceinline__ void attn_core2(const bf16_t* __restrict__ Qb, const bf16_t* __restrict__ Kh, const bf16_t* __restrict__ Vh, char* lds, const int wid, f32x16 (&o)[4], float (&rli)[16]) {
    constexpr int SHM_V = KVBLK * DV * 2, SHM_K = KVBLK * DQK * 2, NQ = DQK / 16, CPR = DQK / 8, NKW = DQK / 64, NT = SEQ / KVBLK, RB = DQK * 2;
    const int lane = lane_id_v(), r32 = lane & 31, hi = lane >> 5; int g = wid >> 2; asm volatile("" : "+s"(g));
    char* V_lds = lds + 3 * SHM_K;
    LAS unsigned char* ldsL = (LAS unsigned char*)lds;
    float* ws = (float*)(lds + 3 * SHM_K + 3 * SHM_V) + wid * 64; float* li_l = ws; float* al_l = ws + 32;
    unsigned koff[NKW], voff[2];
#pragma unroll
    for (int j = 0; j < NKW; ++j) { const int slot = (wid * NKW + j) * 64 + lane, row = slot / CPR, ph = slot % CPR, lc = ph ^ kg(row); koff[j] = (unsigned)(row * LDK + lc * 8) * 2u; }
#pragma unroll
    for (int j = 0; j < 2; ++j) { const int off = (wid * 2 + j) * 1024 + lane * 16, st = off >> 9, o2 = off & 511, kk = (st >> 2) * 8 + (o2 >> 6);
        const int k = kk, c = (st & 3) * 32 + ((o2 & 63) >> 1); voff[j] = (unsigned)(k * LDV + c) * 2u; }
#define DMA_K(tile, b) do { _Pragma("unroll") for (int _j = 0; _j < NKW; ++_j) glds16((const char*)Kh + (size_t)(tile) * (KVBLK * LDK * 2) + koff[_j], (LAS unsigned*)(ldsL + (b) * SHM_K + (wid * NKW + _j) * 1024)); } while (0)
#define DMA_V(tile, b) do { _Pragma("unroll") for (int _j = 0; _j < 2; ++_j) glds16((const char*)Vh + (size_t)(tile) * (KVBLK * LDV * 2) + voff[_j], (LAS unsigned*)(ldsL + 3 * SHM_K + (b) * SHM_V + (wid * 2 + _j) * 1024)); } while (0)
    DMA_K(0, 0); DMA_K(1, 1); DMA_V(0, 0);
    float mhat = 0.f, l_reg = 0; bf16x8 qr[NQ];
#pragma unroll
    for (int d = 0; d < 4; ++d) o[d] = f32x16{};
    const bf16_t* Qw = Qb + (long)((wid * QBLK + r32) * LDQ + hi * 8);
#pragma unroll
    for (int d0 = 0; d0 < NQ; ++d0) qr[d0] = *reinterpret_cast<const bf16x8*>(Qw + d0 * 16);
    const int vb0 = (int)(uintptr_t)V_lds + v_rd_base(lane);
    int ka[4];
#pragma unroll
    for (int b = 0; b < 4; ++b) ka[b] = (int)(uintptr_t)lds + r32 * RB + ((b * 32 + hi * 16) ^ (kg(r32) << 4));
    f32x16 p0, p1; bf16x8 pa0, pa1, pa2, pa3;
    asm volatile("s_waitcnt vmcnt(0)" ::: "memory"); BAR_ALL();
    if (ATT_SKEW && g == 1) BAR_ALL();
#define SEG_M(HASQK, HASPV, kc, vc) do { int ka_[4]; const int vb_ = vb0 + (vc) * (int)SHM_V;                                                          \
        _Pragma("unroll") for (int b_ = 0; b_ < 4; ++b_) ka_[b_] = ka[b_] + (kc) * (int)SHM_K;                                                                     \
        if constexpr (XP == 0 && ATT_SLOTS) seg_m2<DQK, HASQK, HASPV>(ka_, vb_, qr, p0, p1, -mhat, o, pa0, pa1, pa2, pa3); else seg_m<DQK, HASQK, HASPV, XP>(ka_, vb_, qr, p0, p1, -mhat, o, pa0, pa1, pa2, pa3); } while (0)
#define SEG_S(i) do { const int cn_ = (ci == 2) ? 0 : ci + 1, cp_ = (ci == 0) ? 2 : ci - 1;                                              \
        if (!(XP & 4) && !DMA_M) { if ((i) + 2 < NT) DMA_K((i) + 2, cp_); if ((i) + 1 < NT) DMA_V((i) + 1, cn_); } SBAR();                \
        if (ATT_PRIO) __builtin_amdgcn_s_setprio(ATT_PRIO); smax_tile(p0, p1, mhat, l_reg, o, al_l, (i) == 0, r32, hi, pa0, pa1, pa2, pa3); ci = cn_;                                       \
        asm volatile("" : "+v"(l_reg), "+v"(pa0), "+v"(pa1), "+v"(pa2), "+v"(pa3));     \
        if (ATT_PRIO) __builtin_amdgcn_s_setprio(0); BAR_ALL(); } while (0)
    int ci = 0;
    if (DMA_M) { DMA_K(2, 2); DMA_V(1, 1); }
    SEG_M(true, false, 0, 0); BAR_ALL();
#pragma nounroll
    for (int i = 0; i < NT - 1; ++i) {
        SEG_S(i);
        { const int cp = (ci == 0) ? 2 : ci - 1, cn = (ci == 2) ? 0 : ci + 1;
          if (DMA_M) { if (i + 3 < NT) DMA_K(i + 3, cp); if (i + 2 < NT) DMA_V(i + 2, cn); }
          SEG_M(true, true, ci, cp);
          if (DMA_M && i + 3 < NT) asm volatile("s_waitcnt vmcnt(%0)" :: "n"(NKW + 2) : "memory");
          else asm volatile("s_waitcnt vmcnt(0)" ::: "memory");
          BAR_ALL(); }
    }
    SEG_S(NT - 1);
    { const int cp = (ci == 0) ? 2 : ci - 1; SEG_M(false, true, 0, cp); BAR_ALL(); }
#undef SEG_S
#undef SEG_M
    if (ATT_SKEW && g == 0) BAR_ALL();
    if (hi == 0) li_l[r32] = l_reg; asm volatile("s_waitcnt lgkmcnt(0)" ::: "memory");
#pragma unroll
    for (int r = 0; r < 16; ++r) rli[r] = XP ? 0.f : __builtin_amdgcn_rcpf(li_l[crow(r, hi)]);
    asm volatile("s_waitcnt vmcnt(0) lgkmcnt(0)" ::: "memory");
    BAR_ALL();
#undef DMA_K
#undef DMA_V
}
#undef LW2
#undef LW8
#undef BAR_ALL
#undef SBAR
}

#ifndef PH_MASK
#define PH_MASK 0x3ff
#endif
#define PH(k) (((PH_MASK) >> (k)) & 1)
#ifndef PH_ATT
#define PH_ATT 3
#endif
#ifndef REP_MASK
#define REP_MASK 0x000
#endif
#define NREP(k) ((((REP_MASK) >> (k)) & 1) ? 2 : 1)
#ifndef ATT_X
#define ATT_X 0
#endif
#ifndef REP_P6
#define REP_P6 1
#endif
#ifndef REP_MLA
#define REP_MLA 1
#endif
#ifndef REP_DIFF
#define REP_DIFF 1
#endif
struct Args { const float* in[25]; float* out; unsigned char* ws; };

__device__ __forceinline__ void cvt_item(const float* W, int N, int scol, const float* kscale, int k0, bf16_t* WT, int K, int drow0, LAS float* scr, int lane) {
#pragma unroll 8
    for (int i = 0; i < 32; ++i) { const int kk = 2 * i + (lane >> 5); float v = 0.f;
        if (scol >= 0) { v = W[(size_t)(k0 + kk) * N + scol]; if (kscale) v *= kscale[k0 + kk]; }
        scr[kk * 33 + (lane & 31)] = v; }
    LDS_WAIT(); asm volatile("" ::: "memory");
    const int c = lane & 7;
#pragma unroll
    for (int j = 0; j < 4; ++j) { const int n = (lane >> 3) + 8 * j; const LAS float* s = scr + (8 * c) * 33 + n;
        u32x4 o; o.x = pk2(s[0 * 33], s[1 * 33]); o.y = pk2(s[2 * 33], s[3 * 33]); o.z = pk2(s[4 * 33], s[5 * 33]); o.w = pk2(s[6 * 33], s[7 * 33]);
        *(GAS u32x4*)(WT + (size_t)(drow0 + n) * K + k0 + 8 * c) = o; }
    LDS_WAIT(); asm volatile("" ::: "memory");
}
__device__ __forceinline__ int il64(int w) { return (w >> 1) + 32 * (w & 1); }

__global__ void __launch_bounds__(512, 2) hymba_fwd(Args args) {
    extern __shared__ __attribute__((aligned(16))) unsigned char lds[];
    LAS unsigned char* ldsL = (LAS unsigned char*)lds;
    volatile LAS unsigned* MISC = (volatile LAS unsigned*)(ldsL + MISC_OFF);
    const int wave = __builtin_amdgcn_readfirstlane((int)threadIdx.x >> 6);
    const int G = gridDim.x; const int bx = blockIdx.x; const int vcu = (G % 8 == 0) ? (bx % 8) * (G / 8) + bx / 8 : bx;
#define CAS __attribute__((address_space(4)))
#define LOAD_ARGP() const CAS Args* argp = (const CAS Args*)__builtin_amdgcn_kernarg_segment_ptr(); asm volatile("" : "+s"(argp)); unsigned char* const ws = argp->ws; (void)ws
    unsigned* ctl; { LOAD_ARGP(); ctl = (unsigned*)(ws + WS_CTL); }
    { const int t0 = wave * 64 + lane_id_v(); if (t0 < 128) MISC[t0] = 0u; }
    __syncthreads();
    const XcdBarrier bar = xcd_barrier_post(ctl + CW_BAR, MISC + 8, wave);

#define MODP ((float*)(ws + WS_MODP))
#define MOD ((float*)(ws + WS_MOD))
#define MISCW ((float*)(ws + WS_MISC))
#define ROPE ((float*)(ws + WS_ROPE))
#define SSQQ ((float*)(ws + WS_SSQQ))
#define SSQKV ((float*)(ws + WS_SSQKV))
#define WIN ((bf16_t*)(ws + WS_WIN))
#define WQ ((bf16_t*)(ws + WS_WQ))
#define WKV ((bf16_t*)(ws + WS_WKV))
#define WOUT ((bf16_t*)(ws + WS_WOUT))
#define WR ((float*)(ws + WS_WR))
#define WGU ((bf16_t*)(ws + WS_WGU))
#define WDN ((bf16_t*)(ws + WS_WDN))
#define LIST ((int*)(ws + WS_LIST))
#define LISTW ((float*)(ws + WS_LISTW))
#define HB ((bf16_t*)(ws + WS_H))
#define CQ ((bf16_t*)(ws + WS_CQ))
#define CKV ((bf16_t*)(ws + WS_CKV))
#define QA ((bf16_t*)(ws + WS_QA))
#define KA ((bf16_t*)(ws + WS_KA))
#define VA ((bf16_t*)(ws + WS_VA))
#define DQ ((bf16_t*)(ws + WS_DQ))
#define DK ((bf16_t*)(ws + WS_DK))
#define DVb ((bf16_t*)(ws + WS_DV))
#define ATT ((bf16_t*)(ws + WS_ATT))
#define ACT ((bf16_t*)(ws + WS_ACT))
#define YB ((bf16_t*)(ws + WS_Y))
#define STASH ((float*)(ws + WS_STASH))
#define XIN (argp->in[0])
#define XOUT (argp->out)
    unsigned* ECNT = ctl + CW_ECNT;
    const int gw = vcu * 8 + wave, NGW = G * 8;

    _Pragma("unroll") for (int rep_ = 0; rep_ < NREP(0); ++rep_)
    if (PH(0)) {
        const int lane = lane_id_v(), tid = wave * 64 + lane; (void)tid;
        LOAD_ARGP();
        LAS float* scr = (LAS float*)(ldsL + wave * 16384);
        constexpr int I_IN = 16 * (IN_PAD / 32), I_Q = 4 * 24, I_KV = 4 * 32, I_OUT = 16 * 32, I_GU = 16 * 32, I_DN = 8 * 32;
        constexpr int NITEMS = I_IN + I_Q + I_KV + I_OUT + NEXP * (I_GU + I_DN);
        for (int it = gw; it < NITEMS; it += NGW) {
            int r = it; const int l31 = lane & 31;
            if (r < I_IN) { const int nblk = IN_PAD / 32, kb = r / nblk, nb = r % nblk, n = nb * 32 + l31; int sc;
                if (n < 512) sc = n; else if (n < 1536) { const int m = n - 512; sc = 576 + (m & ~63) + il64(m & 63); } else if (n < 2048) sc = 1600 + (n - 1536); else if (n < 2112) sc = 512 + il64(n - 2048); else sc = -1;
                cvt_item(argp->in[5], 2112, sc, nullptr, kb * 64, WIN, 1024, nb * 32, scr, lane); continue; }
            r -= I_IN;
            if (r < I_Q) { const int nblk = 24, kb = r / nblk, nb = r % nblk, n = nb * 32 + l31; const int hd = n / 192, w = n % 192; const int sc = (w < 128) ? n : hd * 192 + 128 + il64(w - 128);
                cvt_item(argp->in[7], 768, sc, argp->in[6], kb * 64, WQ, 256, nb * 32, scr, lane); continue; }
            r -= I_Q;
            if (r < I_KV) { const int nblk = 32, kb = r / nblk, nb = r % nblk;
                cvt_item(argp->in[9], 1024, nb * 32 + l31, argp->in[8], kb * 64, WKV, 256, nb * 32, scr, lane); continue; }
            r -= I_KV;
            if (r < I_OUT) { const int nblk = 32, kb = r / nblk, nb = r % nblk;
                cvt_item(argp->in[15], 1024, nb * 32 + l31, nullptr, kb * 64, WOUT, 1024, nb * 32, scr, lane); continue; }
            r -= I_OUT;
            { const int e = r / (I_GU + I_DN); int q = r % (I_GU + I_DN);
              if (q < I_GU) { const int nblk = 32, kb = q / nblk, nb = q % nblk; const int n0 = nb * 32, pn = n0 >> 8, rr = n0 & 255, bj = rr >> 7, c = rr & 127;
                  const float* src = (bj ? argp->in[22] : argp->in[21]) + (size_t)e * 1024 * 512;
                  cvt_item(src, 512, pn * 128 + c + l31, nullptr, kb * 64, WGU + (size_t)e * 1024 * 1024, 1024, n0, scr, lane); }
              else { q -= I_GU; const int nblk = 32, kb = q / nblk, nb = q % nblk;
                  cvt_item(argp->in[23] + (size_t)e * 512 * 1024, 1024, nb * 32 + l31, nullptr, kb * 64, WDN + (size_t)e * 1024 * 512, 512, nb * 32, scr, lane); } }
        }
        for (int i = bx * 512 + tid; i < 36 * 1024; i += G * 512) { const int j = i >> 10, k = i & 1023;
            WR[i] = (j < 4) ? argp->in[17][k * 4 + j] : argp->in[19][k * 32 + (j - 4)]; }
        for (int i = bx * 512 + tid; i < SEQ * 32; i += G * 512) { const int pos = i >> 5, fi = i & 31;
            const float inv = (float)pow(10000.0, -(double)(2 * fi) / 64.0); const float ang = (float)pos * inv;
            ROPE[2 * i] = (float)cos((double)ang); ROPE[2 * i + 1] = (float)sin((double)ang); }
        for (int it = gw; it < 96 * 8; it += NGW) { const int ng = it % 96, kc = it / 96; const float* cin = argp->in[1];
#pragma unroll
            for (int i = 0; i < 16; ++i) { const int idx = i * 64 + lane, kk = idx >> 3, b = idx & 7; const float cv = cin[b * 1024 + kc * 128 + kk]; scr[idx] = cv / (1.0f + expf(-cv)); }
            LDS_WAIT(); asm volatile("" ::: "memory");
            float a[8] = {0.f, 0.f, 0.f, 0.f, 0.f, 0.f, 0.f, 0.f}; const float* wp = argp->in[2] + (size_t)(kc * 128) * 6144 + ng * 64 + lane;
#pragma unroll 8
            for (int kk = 0; kk < 128; ++kk) { const float w = wp[(size_t)kk * 6144]; const LAS f32x4* sp = (const LAS f32x4*)(scr + kk * 8); const f32x4 s0 = sp[0], s1 = sp[1];
                a[0] += s0[0] * w; a[1] += s0[1] * w; a[2] += s0[2] * w; a[3] += s0[3] * w; a[4] += s1[0] * w; a[5] += s1[1] * w; a[6] += s1[2] * w; a[7] += s1[3] * w; }
#pragma unroll
            for (int b = 0; b < 8; ++b) MODP[((size_t)kc * 8 + b) * 6144 + ng * 64 + lane] = a[b];
            LDS_WAIT(); asm volatile("" ::: "memory");
        }
        if (bx == 0 && wave == 0) { const float a = wave_sum(argp->in[10][lane] * argp->in[11][lane]), b = wave_sum(argp->in[12][lane] * argp->in[13][lane]);
            if (lane == 0) MISCW[0] = expf(a) - expf(b) + 0.2f; }
    }
    xcd_barrier(bar, wave); if (BAR_DBL) xcd_barrier(bar, wave);

    _Pragma("unroll") for (int rep_ = 0; rep_ < NREP(1); ++rep_)
    if (PH(1)) {
        const int lane = lane_id_v(), tid = wave * 64 + lane; (void)tid;
        LOAD_ARGP();
        for (int i = bx * 512 + tid; i < 8 * 6144; i += G * 512) { float s = argp->in[3][i % 6144];
#pragma unroll
            for (int kc = 0; kc < 8; ++kc) s += MODP[(size_t)kc * 8 * 6144 + i];
            MOD[i] = s; }
        for (int p = vcu; p < NPANEL; p += G) { const int b = p >> 5;
            f32x4 av[4], sv[4];
#pragma unroll
            for (int j = 0; j < 4; ++j) { const int c0 = 4 * lane + 256 * j;
#pragma unroll
                for (int q = 0; q < 4; ++q) { float sh = argp->in[3][c0 + q], scl = argp->in[3][1024 + c0 + q];
#pragma unroll
                    for (int kc = 0; kc < 8; ++kc) { sh += MODP[((size_t)kc * 8 + b) * 6144 + c0 + q]; scl += MODP[((size_t)kc * 8 + b) * 6144 + 1024 + c0 + q]; }
                    av[j][q] = argp->in[4][c0 + q] * (1.0f + scl); sv[j][q] = sh; } }
            for (int rr = 0; rr < 32; ++rr) { const size_t row = (size_t)p * 256 + wave * 32 + rr;
                const GAS f32x4* xr = (const GAS f32x4*)(XIN + row * DM) + lane; f32x4 v[4]; float s = 0.f;
#pragma unroll
                for (int j = 0; j < 4; ++j) { v[j] = xr[64 * j]; s += (v[j][0] * v[j][0] + v[j][1] * v[j][1]) + (v[j][2] * v[j][2] + v[j][3] * v[j][3]); }
                const float rstd = 1.0f / sqrtf(wave_sum(s) * (1.0f / DM) + EPS);
                GAS u32x2* o8 = (GAS u32x2*)(HB + row * DM) + lane;
#pragma unroll
                for (int j = 0; j < 4; ++j) { const f32x4 h = v[j] * rstd * av[j] + sv[j]; u32x2 w; w.x = pk2(h[0], h[1]); w.y = pk2(h[2], h[3]); o8[64 * j] = w; } }
        }
    }
    xcd_barrier(bar, wave); if (BAR_DBL) xcd_barrier(bar, wave);

    _Pragma("unroll") for (int rep_ = 0; rep_ < NREP(2); ++rep_)
    if (PH(2)) {
        const int lane = lane_id_v(), tid = wave * 64 + lane; (void)tid;
        LOAD_ARGP();
        pg8::StaticOrder S; S.init(T_TOK, IN_PAD, G, bx);
        pg8::EpiG1 E{CQ, CKV, DQ, DK, DVb, KA, SSQQ, SSQKV, ROPE};
        pg8::gemm_phase<pg8::EpiG1, pg8::StaticOrder, false>(ldsL, wave, HB, DM, WIN, DM, 0, DM, S, E);
    }
    xcd_barrier(bar, wave); if (BAR_DBL) xcd_barrier(bar, wave);

    _Pragma("unroll") for (int rep_ = 0; rep_ < NREP(3); ++rep_)
    if (PH(3)) {
        const int lane = lane_id_v(), tid = wave * 64 + lane; (void)tid;
        LOAD_ARGP();
        { pg8::StaticOrder S; S.init(T_TOK, 768, G, bx); pg8::EpiQ E{QA, SSQQ, ROPE};
          pg8::gemm_phase<pg8::EpiQ, pg8::StaticOrder, false>(ldsL, wave, CQ, 256, WQ, 256, 0, 256, S, E); }
        { pg8::StaticOrder S; S.init(T_TOK, 1024, G, bx); pg8::EpiKV E{KA, VA, SSQKV};
          pg8::gemm_phase<pg8::EpiKV, pg8::StaticOrder, false>(ldsL, wave, CKV, 256, WKV, 256, 0, 256, S, E); }
    }
    xcd_barrier(bar, wave); if (BAR_DBL) xcd_barrier(bar, wave);

    if (PH(4)) {
        const int lane = lane_id_v(), tid = wave * 64 + lane; (void)tid;
        LOAD_ARGP();
        const int r32 = lane & 31, hi = lane >> 5;
        const float lam = MISCW[0];
#if PH_ATT & 1
#if ATT_X
        for (int u = vcu; u < 1024; u += G) {
            const int bhi = u >> 5, qb = u & 31;
            f32x16 o[4]; float rli[16];
            const int b = bhi >> 2, h = bhi & 3; const size_t tok0 = (size_t)b * SEQ;
            att::attn_core2<192, 768, 768, 512, ATT_X>(QA + (tok0 + qb * 256) * 768 + h * 192, KA + tok0 * 768 + h * 192, VA + tok0 * 512 + h * 128, (char*)lds, wave, o, rli);
            GAS bf16_t* Ow = (GAS bf16_t*)(ATT + (tok0 + qb * 256 + wave * 32 + 4 * hi) * DM + h * 128 + r32);
            asm volatile("" : "+v"(Ow));
#pragma unroll
            for (int r = 0; r < 16; ++r) {
#pragma unroll
                for (int d0 = 0; d0 < 4; ++d0) Ow[(size_t)((r & 3) + 8 * (r >> 2)) * DM + d0 * 32] = (bf16_t)f2bf(o[d0][r] * rli[r]); }
        }
#endif
        for (int rep = 0; rep < REP_MLA; ++rep)
        for (int u = vcu; u < 1024; u += G) {
            const int bhi = u >> 5, qb = u & 31;
            f32x16 o[4]; float rli[16];
            const int b = bhi >> 2, h = bhi & 3; const size_t tok0 = (size_t)b * SEQ;
            att::attn_core2<192, 768, 768, 512>(QA + (tok0 + qb * 256) * 768 + h * 192, KA + tok0 * 768 + h * 192, VA + tok0 * 512 + h * 128, (char*)lds, wave, o, rli);
            GAS bf16_t* Ow = (GAS bf16_t*)(ATT + (tok0 + qb * 256 + wave * 32 + 4 * hi) * DM + h * 128 + r32);
            asm volatile("" : "+v"(Ow));
#pragma unroll
            for (int r = 0; r < 16; ++r) {
#pragma unroll
                for (int d0 = 0; d0 < 4; ++d0) Ow[(size_t)((r & 3) + 8 * (r >> 2)) * DM + d0 * 32] = (bf16_t)f2bf(o[d0][r] * rli[r]); }
        }
#endif
#if PH_ATT & 2
        for (int rep = 0; rep < REP_DIFF; ++rep)
        for (int it = 0;; ++it) {
            const int u = vcu + (it >> 1) * G, j = it & 1;
            if (u >= 1024) break;
            const int bh = u >> 5, qb = u & 31, b = bh >> 2, h = bh & 3; const size_t tok0 = (size_t)b * SEQ;
            f32x16 o[4]; float rli[16];
            GAS float* st = (GAS float*)(STASH + ((size_t)bx * 8 + wave) * 4096 + lane);
            att::attn_core2<64, 512, 512, 512, 0, DIFF_DMA_M>(DQ + (tok0 + qb * 256) * 512 + h * 128 + j * 64, DK + tok0 * 512 + h * 128 + j * 64, DVb + tok0 * 512 + h * 128, (char*)lds, wave, o, rli);
            asm volatile("" : "+v"(st));
            if (j == 0) {
#pragma unroll
                for (int d0 = 0; d0 < 4; ++d0)
#pragma unroll
                    for (int r = 0; r < 16; ++r) st[(d0 * 16 + r) * 64] = o[d0][r] * rli[r];
                VM_WAIT();
            } else {
                float gsub[4];
#pragma unroll
                for (int d0 = 0; d0 < 4; ++d0) gsub[d0] = argp->in[14][d0 * 32 + r32] * 0.8f;
                GAS bf16_t* Ow = (GAS bf16_t*)(ATT + (tok0 + qb * 256 + wave * 32 + 4 * hi) * DM + 512 + h * 128 + r32);
                asm volatile("" : "+v"(Ow));
#pragma unroll
                for (int r = 0; r < 16; ++r) { float v[4]; float s = 0.f;
                    if ((r & 3) == 0) asm volatile("" ::: "memory");
#pragma unroll
                    for (int d0 = 0; d0 < 4; ++d0) { v[d0] = __hip_atomic_load(st + (d0 * 16 + r) * 64, RLX_AGENT) - lam * (o[d0][r] * rli[r]); s += v[d0] * v[d0]; }
#pragma unroll
                    for (int of = 1; of < 32; of <<= 1) s += __shfl_xor(s, of);
                    const float rstd = 1.0f / sqrtf(s * (1.0f / 128.0f) + EPS);
#pragma unroll
                    for (int d0 = 0; d0 < 4; ++d0) Ow[(size_t)((r & 3) + 8 * (r >> 2)) * DM + d0 * 32] = (bf16_t)f2bf(v[d0] * rstd * gsub[d0]); }
                VM_WAIT();
            }
        }
#endif
    }
    xcd_barrier(bar, wave); if (BAR_DBL) xcd_barrier(bar, wave);

    _Pragma("unroll") for (int rep_ = 0; rep_ < NREP(5); ++rep_)
    if (PH(5)) {
        const int lane = lane_id_v(), tid = wave * 64 + lane; (void)tid;
        LOAD_ARGP();
        pg8::StaticOrder S; S.init(T_TOK, DM, G, bx);
        pg8::EpiX1 E{XIN, XOUT, MOD};
        pg8::gemm_phase<pg8::EpiX1, pg8::StaticOrder, false>(ldsL, wave, ATT, DM, WOUT, DM, 0, DM, S, E);
    }
    xcd_barrier(bar, wave); if (BAR_DBL) xcd_barrier(bar, wave);

    if (PH(6)) {
        LOAD_ARGP();
        LAS f32x4* WE4 = (LAS f32x4*)ldsL;
        LAS f32x4* WG4 = (LAS f32x4*)(ldsL + 131072);
        LAS int* selE = (LAS int*)(ldsL + 147456);
        LAS float* selW = (LAS float*)(ldsL + 147456 + 2048);
        LAS int* selP = (LAS int*)(ldsL + 147456 + 4096);
        LAS int* lcnt = (LAS int*)(ldsL + 147456 + 6144);
        LAS int* lbase = (LAS int*)(ldsL + 147456 + 6144 + 128);
        LAS float* biasL = (LAS float*)(ldsL + 147456 + 6144 + 256);
        const float* Wg = argp->in[17]; const float* We = argp->in[19];
        for (int p = vcu; p < NPANEL; p += G) { const int b = p >> 5;
            const int lane = lane_id_v(), tid = wave * 64 + lane;
            const float* scl2 = MOD + (size_t)(b * 6 + 4) * DM; const float* sh2 = MOD + (size_t)(b * 6 + 3) * DM; const float* g2p = argp->in[16];
            if (tid < 32) lcnt[tid] = 0;
            for (int i = tid; i < 1024 * 32; i += 512) { const int k = i >> 5, n = i & 31; const float a2 = g2p[k] * (1.0f + scl2[k]);
                ((LAS float*)WE4)[(((k >> 3) * 2 + ((k >> 2) & 1)) * 32 + n) * 4 + (k & 3)] = a2 * We[i]; }
            for (int i = tid; i < 1024 * 4; i += 512) { const int k = i >> 2; const float a2 = g2p[k] * (1.0f + scl2[k]); ((LAS float*)WG4)[i] = a2 * Wg[i]; }
            for (int n = wave; n < 36; n += 8) { float a = 0.f;
#pragma unroll
                for (int q = 0; q < 16; ++q) { const int k = lane + 64 * q; a += sh2[k] * ((n < 4) ? Wg[k * 4 + n] : We[k * 32 + (n - 4)]); }
                a = wave_sum(a); if (lane == 0) biasL[n] = a + ((n < 4) ? argp->in[18][n] : argp->in[20][n - 4]); }
            __syncthreads();
            int lane1 = lane; asm volatile("" : "+v"(lane1));
            const int r32 = lane1 & 31, khalf = lane1 >> 5; const int rl = wave * 32 + r32; const size_t row = (size_t)p * 256 + rl;
            const GAS f32x4* xp = (const GAS f32x4*)(XOUT + row * DM) + khalf;
            f32x16 acc = f32x16{}; float gl0 = 0.f, gl1 = 0.f, gl2 = 0.f, gl3 = 0.f, ssq = 0.f;
#define P6_STEP(X, m) do { const f32x4 W = WE4[(m) * 64 + lane1]; const LAS f32x4* gp = WG4 + ((m) * 2 + khalf) * 4; const f32x4 G0 = gp[0], G1 = gp[1], G2 = gp[2], G3 = gp[3];                \
                acc = __builtin_amdgcn_mfma_f32_32x32x2f32(W[0], X[0], acc, 0, 0, 0); acc = __builtin_amdgcn_mfma_f32_32x32x2f32(W[1], X[1], acc, 0, 0, 0);                                        \
                acc = __builtin_amdgcn_mfma_f32_32x32x2f32(W[2], X[2], acc, 0, 0, 0); acc = __builtin_amdgcn_mfma_f32_32x32x2f32(W[3], X[3], acc, 0, 0, 0);                                        \
                gl0 += X[0] * G0[0] + X[1] * G1[0] + X[2] * G2[0] + X[3] * G3[0]; gl1 += X[0] * G0[1] + X[1] * G1[1] + X[2] * G2[1] + X[3] * G3[1];                                                \
                gl2 += X[0] * G0[2] + X[1] * G1[2] + X[2] * G2[2] + X[3] * G3[2]; gl3 += X[0] * G0[3] + X[1] * G1[3] + X[2] * G2[3] + X[3] * G3[3];                                                \
                ssq += (X[0] * X[0] + X[1] * X[1]) + (X[2] * X[2] + X[3] * X[3]); if ((m) & 1) asm volatile("" ::: "memory"); } while (0)
            f32x4 Xa[4], Xb[4];
#pragma unroll
            for (int q = 0; q < 4; ++q) Xa[q] = xp[2 * q];
#pragma nounroll
            for (int mg = 0; mg < 128; mg += 8) {
                const int mn = (mg + 8 < 128) ? mg + 8 : 120;
#pragma unroll
                for (int q = 0; q < 4; ++q) Xb[q] = xp[2 * (mg + 4 + q)];
#pragma unroll
                for (int q = 0; q < 4; ++q) P6_STEP(Xa[q], mg + q);
#pragma unroll
                for (int q = 0; q < 4; ++q) Xa[q] = xp[2 * (mn + q)];
#pragma unroll
                for (int q = 0; q < 4; ++q) P6_STEP(Xb[q], mg + 4 + q);
            }
#undef P6_STEP
#define XSUM(v) do { auto rr_ = __builtin_amdgcn_permlane32_swap(__float_as_uint(v), __float_as_uint(v), false, false); v = __uint_as_float(rr_[0]) + __uint_as_float(rr_[1]); } while (0)
            XSUM(ssq); XSUM(gl0); XSUM(gl1); XSUM(gl2); XSUM(gl3);
#undef XSUM
            const float rstd = 1.0f / sqrtf(ssq * (1.0f / DM) + EPS);
            { float lg0 = rstd * gl0 + biasL[0], lg1 = rstd * gl1 + biasL[1], lg2 = rstd * gl2 + biasL[2], lg3 = rstd * gl3 + biasL[3];
              int gi = 0; float gm = lg0; if (lg1 > gm) { gm = lg1; gi = 1; } if (lg2 > gm) { gm = lg2; gi = 2; } if (lg3 > gm) { gm = lg3; gi = 3; }
              const float gprob = 1.0f / (expf(lg0 - gm) + expf(lg1 - gm) + expf(lg2 - gm) + expf(lg3 - gm));
              float mine[4], oth[4];
#pragma unroll
              for (int q = 0; q < 4; ++q) { const float c = (gi == 0) ? acc[q] : (gi == 1) ? acc[4 + q] : (gi == 2) ? acc[8 + q] : acc[12 + q];
                  mine[q] = rstd * c + biasL[4 + gi * 8 + khalf * 4 + q];
                  auto rr_ = __builtin_amdgcn_permlane32_swap(__float_as_uint(mine[q]), __float_as_uint(mine[q]), false, false);
                  oth[q] = khalf ? __uint_as_float(rr_[0]) : __uint_as_float(rr_[1]); }
              float es[8];
#pragma unroll
              for (int j = 0; j < 8; ++j) es[j] = ((j >> 2) == khalf) ? mine[j & 3] : oth[j & 3];
              int i0 = 0; float l0 = es[0];
#pragma unroll
              for (int j = 1; j < 8; ++j) if (es[j] > l0) { l0 = es[j]; i0 = j; }
              int i1 = -1; float l1 = -3.0e38f;
#pragma unroll
              for (int j = 0; j < 8; ++j) if (j != i0 && (i1 < 0 || es[j] > l1)) { l1 = es[j]; i1 = j; }
              const float ex = expf(l1 - l0); const float w0 = gprob / (1.0f + ex), w1 = gprob * ex / (1.0f + ex);
              if (khalf == 0) { const int e0 = gi * 8 + i0, e1 = gi * 8 + i1;
                  selE[rl * 2] = e0; selE[rl * 2 + 1] = e1; selW[rl * 2] = w0; selW[rl * 2 + 1] = w1;
                  selP[rl * 2] = __hip_atomic_fetch_add(lcnt + e0, 1, __ATOMIC_RELAXED, __HIP_MEMORY_SCOPE_WORKGROUP);
                  selP[rl * 2 + 1] = __hip_atomic_fetch_add(lcnt + e1, 1, __ATOMIC_RELAXED, __HIP_MEMORY_SCOPE_WORKGROUP); } }
            { f32x4 av[4], sv[4]; int lane2 = lane; asm volatile("" : "+v"(lane2));
#pragma unroll
              for (int j = 0; j < 4; ++j) { const int c0 = 4 * lane2 + 256 * j; sv[j] = *(const f32x4*)(sh2 + c0); av[j] = *(const f32x4*)(g2p + c0) * (1.0f + *(const f32x4*)(scl2 + c0)); }
              for (int rr = 0; rr < 32; ++rr) { const size_t row2 = (size_t)p * 256 + wave * 32 + rr; const float rs = __int_as_float(__builtin_amdgcn_readlane(__float_as_int(rstd), rr));
                  const GAS f32x4* xr = (const GAS f32x4*)(XOUT + row2 * DM) + lane2; GAS u32x2* o8 = (GAS u32x2*)(HB + row2 * DM) + lane2;
#pragma unroll
                  for (int j = 0; j < 4; ++j) { const f32x4 h = xr[64 * j] * rs * av[j] + sv[j]; u32x2 w; w.x = pk2(h[0], h[1]); w.y = pk2(h[2], h[3]); o8[64 * j] = w; } } }
            __syncthreads();
            const int tidB = wave * 64 + lane_id_v();
            if (tidB < 32) lbase[tidB] = (int)__hip_atomic_fetch_add(ECNT + tidB, (unsigned)lcnt[tidB], RLX_AGENT);
            __syncthreads();
            { const int tid = tidB; const int rl = tid >> 1, k = tid & 1; const int e = selE[tid]; const int pos = lbase[e] + selP[tid];
              LIST[e * LCAP + pos] = ((p * 256 + rl) << 1) | k; LISTW[e * LCAP + pos] = selW[tid]; }
            __syncthreads();
        }
    }
    xcd_barrier(bar, wave); if (BAR_DBL) xcd_barrier(bar, wave);

    _Pragma("unroll") for (int rep_ = 0; rep_ < NREP(7); ++rep_)
    if (PH(7)) {
        const int lane = lane_id_v(), tid = wave * 64 + lane; (void)tid;
        LOAD_ARGP();
        pg8::MoeOrder S; S.init(ECNT, LIST, G, vcu);
        pg8::EpiAct E{ACT};
        pg8::gemm_phase<pg8::EpiAct, pg8::MoeOrder, true>(ldsL, wave, HB, DM, WGU, DM, (size_t)1024 * 1024, DM, S, E);
    }
    xcd_barrier(bar, wave); if (BAR_DBL) xcd_barrier(bar, wave);

    _Pragma("unroll") for (int rep_ = 0; rep_ < NREP(8); ++rep_)
    if (PH(8)) {
        const int lane = lane_id_v(), tid = wave * 64 + lane; (void)tid;
        LOAD_ARGP();
        pg8::MoeOrder S; S.init(ECNT, LIST, G, vcu);
        pg8::EpiDown E{YB, LIST, LISTW};
        pg8::gemm_phase<pg8::EpiDown, pg8::MoeOrder, false>(ldsL, wave, ACT, DEXP, WDN, DEXP, (size_t)1024 * 512, DEXP, S, E);
    }
    xcd_barrier(bar, wave); if (BAR_DBL) xcd_barrier(bar, wave);

    if (PH(9)) {
        const int lane = lane_id_v(), tid = wave * 64 + lane; (void)tid;
        LOAD_ARGP();
        const bool bad = xb_ld(ctl + CW_BAR + XB_TMO) != 0u;
        for (int p = vcu; p < NPANEL; p += G) { const int b = p >> 5;
            f32x4 gv[4], fv[4];
#pragma unroll
            for (int j = 0; j < 4; ++j) { const int c0 = 4 * lane + 256 * j; gv[j] = *(const f32x4*)(MOD + (size_t)(b * 6 + 5) * DM + c0); fv[j] = *(const f32x4*)(argp->in[24] + c0); }
            for (int rr = 0; rr < 32; ++rr) { const size_t row = (size_t)p * 256 + wave * 32 + rr;
                GAS f32x4* xr = (GAS f32x4*)(XOUT + row * DM) + lane; const GAS u32x2* y0 = (const GAS u32x2*)(YB + (row * 2) * DM) + lane; const GAS u32x2* y1 = (const GAS u32x2*)(YB + (row * 2 + 1) * DM) + lane;
                f32x4 v[4]; float s = 0.f;
#pragma unroll
                for (int j = 0; j < 4; ++j) { const f32x4 xv = xr[64 * j]; const u32x2 a = y0[64 * j], c = y1[64 * j];
                    f32x4 ys; ys[0] = bf_lo(a.x) + bf_lo(c.x); ys[1] = bf_hi(a.x) + bf_hi(c.x); ys[2] = bf_lo(a.y) + bf_lo(c.y); ys[3] = bf_hi(a.y) + bf_hi(c.y);
                    v[j] = xv + gv[j] * ys; s += (v[j][0] * v[j][0] + v[j][1] * v[j][1]) + (v[j][2] * v[j][2] + v[j][3] * v[j][3]); }
                const float rstd = 1.0f / sqrtf(wave_sum(s) * (1.0f / DM) + EPS);
#pragma unroll
                for (int j = 0; j < 4; ++j) { f32x4 o = v[j] * rstd * fv[j]; if (bad) o = (f32x4){__builtin_nanf(""), __builtin_nanf(""), __builtin_nanf(""), __builtin_nanf("")}; xr[64 * j] = o; } }
        }
    }
}
#undef MODP
#undef MOD
#undef MISCW
#undef ROPE
#undef SSQQ
#undef SSQKV
#undef WIN
#undef WQ
#undef WKV
#undef WOUT
#undef WR
#undef WGU
#undef WDN
#undef LIST
#undef LISTW
#undef HB
#undef CQ
#undef CKV
#undef QA
#undef KA
#undef VA
#undef DQ
#undef DK
#undef DVb
#undef ATT
#undef ACT
#undef YB
#undef STASH
#undef XIN
#undef XOUT
#undef CAS
#undef LOAD_ARGP

extern "C" void kernel_launch(void* const* d_in, const int* in_sizes, int n_in, void* d_out, int out_size, void* d_ws, size_t ws_size, hipStream_t stream) {
    static int grid = 0;
    if (grid == 0) {
        if (n_in != 25 || in_sizes[0] != T_TOK * DM || out_size != T_TOK * DM || ws_size < WS_END) {
            fprintf(stderr, "kernel_launch: shape mismatch (n_in %d, in0 %d, out %d, ws %zu, need %zu)\n", n_in, n_in > 0 ? in_sizes[0] : -1, out_size, ws_size, (size_t)WS_END); grid = -1; return; }
        int dev = 0, cus = 0, per_cu = 0;
        if (hipGetDevice(&dev) != hipSuccess || hipDeviceGetAttribute(&cus, hipDeviceAttributeMultiprocessorCount, dev) != hipSuccess) { grid = -1; return; }
        if (hipFuncSetAttribute((const void*)hymba_fwd, hipFuncAttributeMaxDynamicSharedMemorySize, LDS_BYTES) != hipSuccess) { fprintf(stderr, "kernel_launch: hipFuncSetAttribute failed\n"); grid = -1; return; }
        if (hipOccupancyMaxActiveBlocksPerMultiprocessor(&per_cu, (const void*)hymba_fwd, 512, LDS_BYTES) != hipSuccess || per_cu < 1)
            fprintf(stderr, "kernel_launch: note: occupancy query reports %d\n", per_cu);
        (void)hipGetLastError();
        grid = cus;
    }
    if (grid < 0) return;
    if (hipMemsetAsync((char*)d_ws + WS_CTL, 0, CTL_ZERO_BYTES, stream) != hipSuccess) return;
    Args a{};
    for (int i = 0; i < 25; ++i) a.in[i] = (const float*)d_in[i];
    a.out = (float*)d_out; a.ws = (unsigned char*)d_ws;
    hipLaunchKernelGGL(hymba_fwd, dim3(grid), dim3(512), LDS_BYTES, stream, a);
    const hipError_t le = hipPeekAtLastError();
    if (le != hipSuccess) fprintf(stderr, "kernel_launch: launch failed: %s\n", hipGetErrorName(le));
}
```

```cpp
#include <hip/hip_runtime.h>
#include <cstdio>
#include <cstdint>
#ifndef ATT_PRIO
#define ATT_PRIO 0
#endif
#ifndef BAR_DBL
#define BAR_DBL 0
#endif
#ifndef DIFF_DMA_M
#define DIFF_DMA_M false
#endif
#ifndef ATT_SLOTS
#define ATT_SLOTS 1
#endif
#ifndef ATT_SKEW
#define ATT_SKEW 1
#endif
#ifndef ATT_X
#define ATT_X 0
#endif

#define GAS __attribute__((address_space(1)))
#define LAS __attribute__((address_space(3)))
typedef unsigned short bf16_t;
typedef short bf16x8 __attribute__((ext_vector_type(8)));
typedef short s16x4 __attribute__((ext_vector_type(4)));
typedef float f32x2 __attribute__((ext_vector_type(2)));
typedef float f32x4 __attribute__((ext_vector_type(4)));
typedef float f32x16 __attribute__((ext_vector_type(16)));
typedef unsigned u32x2 __attribute__((ext_vector_type(2)));
typedef unsigned u32x4 __attribute__((ext_vector_type(4)));

constexpr int NB = 8, SEQ = 8192, DM = 1024, T_TOK = NB * SEQ;
constexpr int IN_PAD = 2304;
constexpr int NEXP = 32, DEXP = 512, LCAP = 65536;
constexpr float EPS = 1e-6f;
constexpr int NPANEL = T_TOK / 256;
constexpr float QSC_MLA = 0.07216878364870322f * 1.4426950408889634f, QSC_DIFF = 0.125f * 1.4426950408889634f;

constexpr size_t MiB = 1u << 20;
constexpr size_t WS_CTL = 0, CTL_ZERO_BYTES = 1 * MiB;
constexpr size_t WS_MODP = 1 * MiB;
constexpr size_t WS_MOD = 3 * MiB;
constexpr size_t WS_MISC = 3 * MiB + 512 * 1024;
constexpr size_t WS_ROPE = 4 * MiB;
constexpr size_t WS_SSQQ = 6 * MiB, WS_SSQKV = 7 * MiB;
constexpr size_t WS_WIN = 8 * MiB;
constexpr size_t WS_WQ = 13 * MiB;
constexpr size_t WS_WKV = 13 * MiB + 512 * 1024;
constexpr size_t WS_WOUT = 14 * MiB;
constexpr size_t WS_WR = 16 * MiB;
constexpr size_t WS_WGU = 24 * MiB;
constexpr size_t WS_WDN = 88 * MiB;
constexpr size_t WS_LIST = 120 * MiB;
constexpr size_t WS_H = 128 * MiB;
constexpr size_t WS_CQ = 256 * MiB, WS_CKV = 288 * MiB, WS_QA = 320 * MiB, WS_KA = 416 * MiB, WS_VA = 512 * MiB;
constexpr size_t WS_DQ = 576 * MiB, WS_DK = 640 * MiB, WS_DV = 704 * MiB, WS_ATT = 768 * MiB;
constexpr size_t WS_ACT = 256 * MiB;
constexpr size_t WS_Y = 400 * MiB;
constexpr size_t WS_LISTW = 896 * MiB;
constexpr size_t WS_STASH = 904 * MiB;
constexpr size_t WS_END = 936 * MiB;
constexpr int CW_BAR = 4096;
constexpr int CW_ECNT = 16384;

constexpr int LDS_BYTES = 163840;
constexpr int MISC_OFF = LDS_BYTES - 512;

#define RLX_AGENT __ATOMIC_RELAXED, __HIP_MEMORY_SCOPE_AGENT
#define LDS_WAIT() asm volatile("s_waitcnt lgkmcnt(0)" ::: "memory")
#define VM_WAIT() asm volatile("s_waitcnt vmcnt(0)" ::: "memory")
__device__ __forceinline__ unsigned f2bf(float f) { unsigned u = __builtin_bit_cast(unsigned, f); return (u + 0x7fffu + ((u >> 16) & 1u)) >> 16; }
__device__ __forceinline__ unsigned pk2(float lo, float hi) { return f2bf(lo) | (f2bf(hi) << 16); }
__device__ __forceinline__ unsigned cvt_pk_bf16(float lo, float hi) { unsigned r; asm volatile("v_cvt_pk_bf16_f32 %0, %1, %2" : "=v"(r) : "v"(lo), "v"(hi)); return r; }
__device__ __forceinline__ float bf_lo(unsigned w) { return __builtin_bit_cast(float, w << 16); }
__device__ __forceinline__ float bf_hi(unsigned w) { return __builtin_bit_cast(float, w & 0xffff0000u); }
__device__ __forceinline__ int lane_id_v() { int l; asm volatile("v_mbcnt_lo_u32_b32 %0, -1, 0\n\tv_mbcnt_hi_u32_b32 %0, -1, %0" : "=v"(l)); return l; }
__device__ __forceinline__ float wave_sum(float v) {
#pragma unroll
    for (int o = 1; o < 64; o <<= 1) v += __shfl_xor(v, o);
    return v;
}

#define XB_TMO      128
#define XB_XCNT(j)  (256  + 64 * (j))
#define XB_XSUB(j)  (1280 + 64 * (j))
#define XB_XGEN(j)  (2304 + 64 * (j))
#define XB_TOP      3328
#define XB_TOPGEN   3392
#define XCD_BAR_WORDS 3456
#define XB_SPIN_CAP (1u << 18)
__device__ __forceinline__ unsigned xb_ld(unsigned* p)              { return __hip_atomic_load(p, __ATOMIC_RELAXED, __HIP_MEMORY_SCOPE_AGENT); }
__device__ __forceinline__ unsigned xb_add(unsigned* p, unsigned v) { return __hip_atomic_fetch_add(p, v, __ATOMIC_RELAXED, __HIP_MEMORY_SCOPE_AGENT); }
__device__ __forceinline__ unsigned xb_xcc_id() { return (unsigned)__builtin_amdgcn_s_getreg((3 << 11) | 20) & 0xFu; }
#define XB_SPIN(cond, bar) do { unsigned _sp = 0; while (cond) { __builtin_amdgcn_s_sleep(1); \
    if ((++_sp & 255u) == 0u) { if (xb_ld(&(bar)[XB_TMO])) break; if (_sp > XB_SPIN_CAP) { atomicAdd(&(bar)[XB_TMO], 1u); break; } } } } while (0)
struct XcdBarrier { unsigned* bar; unsigned x; volatile LAS unsigned* st; };
__device__ __forceinline__ XcdBarrier xcd_barrier_post(unsigned* bar, volatile LAS unsigned* st, int wave) {
    XcdBarrier b; b.bar = bar; b.x = xb_xcc_id(); b.st = st;
    if (wave == 0 && lane_id_v() == 0) (void)xb_add(&bar[XB_XCNT(b.x)], 1u);
    return b;
}
__device__ __forceinline__ void xcd_barrier_complete(unsigned* bar, unsigned x, unsigned& nloc, unsigned& nx) {
    const unsigned G = gridDim.x * gridDim.y * gridDim.z;
    unsigned sum, cnt, mine, sp = 0u;
    for (;;) {
        sum = 0u; cnt = 0u; mine = 0u;
#pragma unroll
        for (unsigned j = 0; j < 16; ++j) { const unsigned c = xb_ld(&bar[XB_XCNT(j)]); sum += c; cnt += (c > 0u) ? 1u : 0u; mine = (j == x) ? c : mine; }
        if (sum == G) break;
        __builtin_amdgcn_s_sleep(1);
        if ((++sp & 255u) == 0u) { if (xb_ld(&bar[XB_TMO])) break; if (sp > XB_SPIN_CAP) { atomicAdd(&bar[XB_TMO], 1u); break; } }
    }
    nloc = mine > 0u ? mine : 1u; nx = cnt > 0u ? cnt : 1u;
}
__device__ __forceinline__ void xcd_barrier(const XcdBarrier& b, int wave) {
    asm volatile("s_waitcnt vmcnt(0)" ::: "memory");
    __syncthreads();
    if (wave == 0 && lane_id_v() == 0) {
        unsigned* bar = b.bar;
        __builtin_amdgcn_s_waitcnt(0);
        unsigned nloc = b.st[0], nx = b.st[1];
        if (nloc == 0u) { xcd_barrier_complete(bar, b.x, nloc, nx); b.st[0] = nloc; b.st[1] = nx; }
        const unsigned old = xb_add(&bar[XB_XSUB(b.x)], 1u);
        const unsigned gen = old / nloc;
        if (old + 1u == (gen + 1u) * nloc) {
            __builtin_amdgcn_fence(__ATOMIC_RELEASE, "agent");
            asm volatile("s_waitcnt vmcnt(0)" ::: "memory");
            const unsigned og = xb_add(&bar[XB_TOP], 1u);
            const unsigned tg = og / nx;
            if (og + 1u == (tg + 1u) * nx) xb_add(&bar[XB_TOPGEN], 1u);
            else XB_SPIN(xb_ld(&bar[XB_TOPGEN]) == tg, bar);
            __builtin_amdgcn_fence(__ATOMIC_ACQUIRE, "agent");
            xb_add(&bar[XB_XGEN(b.x)], 1u);
            asm volatile("s_waitcnt vmcnt(0)" ::: "memory");
        } else {
            XB_SPIN(xb_ld(&bar[XB_XGEN(b.x)]) == gen, bar);
            __builtin_amdgcn_fence(__ATOMIC_ACQUIRE, "agent");
            asm volatile("s_waitcnt vmcnt(0)" ::: "memory");
        }
    }
    __syncthreads();
}

namespace pg8 {
constexpr int BM = 256, BK = 64, HALF = 128, HTB = HALF * BK * 2, STAGE_BYTES = 8 * HTB, NXCD = 8, WGM = 8;
__host__ __device__ __forceinline__ int lds_byte(int r, int c) { const int st = (r >> 4) * 2 + (c >> 5), rr = r & 15, cc = c & 31, ob = rr * 64 + cc * 2; return st * 1024 + (ob ^ (((ob >> 9) & 1) << 5)); }
__host__ __device__ __forceinline__ void stage_rc(int b, int& R, int& C) { const int st = b / 1024, sb = b % 1024, swz = sb ^ (((sb >> 9) & 1) << 5); R = (st >> 1) * 16 + swz / 64; C = (st & 1) * 32 + (swz % 64) / 2; }
__host__ __device__ __forceinline__ int perm32(int rho) { const int n = rho >> 4, i = rho & 15; return 8 * (i >> 2) + 4 * n + (i & 3); }

struct Unit { int pm, pn, e, t, cnt; };

struct StaticOrder {
    int nM, nN, nwg, G, c;
    __device__ void init(int M, int N, int G_, int c_) { nM = M / BM; nN = N / BM; nwg = nM * nN; G = G_; c = c_; }
    __device__ bool next(int i, Unit& u) const {
        const long L = (long)i * G + c; if (L >= nwg) return false;
        int wgid = (int)L; { const int q = nwg / NXCD, r = nwg % NXCD, xcd = wgid % NXCD, off = wgid / NXCD; wgid = (xcd < r ? xcd * (q + 1) : r * (q + 1) + (xcd - r) * q) + off; }
        const int nig = WGM * nN, gid = wgid / nig, fm = gid * WGM, gsz = (nM - fm) < WGM ? (nM - fm) : WGM;
        u.pm = fm + ((wgid % nig) % gsz); u.pn = (wgid % nig) / gsz; u.e = 0; u.t = u.pm; u.cnt = 0x7fffffff; return true;
    }
    __device__ __forceinline__ int gather(const Unit&, int) const { return 0; }
};
struct MoeOrder {
    const int* list; int endv, cntv, total, G, vcu;
    __device__ void init(const unsigned* ecnt, const int* list_, int G_, int vcu_) {
        list = list_; G = G_; vcu = vcu_;
        const int lane = lane_id_v();
        int c = (lane < NEXP) ? (int)__hip_atomic_load(ecnt + lane, RLX_AGENT) : 0;
        cntv = c; int v = (c + 255) >> 8;
#pragma unroll
        for (int o = 1; o < 64; o <<= 1) { const int t = __shfl_up(v, o); if (lane >= o) v += t; }
        endv = v; total = __builtin_amdgcn_readlane(v, 63);
    }
    __device__ bool next(int i, Unit& u) const {
        const int L = i * G + vcu; const int ti = L >> 2; if (ti >= total) return false;
        const int lane = lane_id_v();
        const unsigned long long m = __ballot(lane < NEXP && endv <= ti);
        const int e = __builtin_amdgcn_readfirstlane(__builtin_popcountll(m));
        const int base = e ? __builtin_amdgcn_readlane(endv, e - 1) : 0;
        u.pm = ti; u.pn = L & 3; u.e = e; u.t = ti - base; u.cnt = __builtin_amdgcn_readlane(cntv, e); return true;
    }
    __device__ __forceinline__ int gather(const Unit& u, int rr) const {
        const int idx = u.t * 256 + rr;
        return idx < u.cnt ? (list[u.e * LCAP + idx] >> 1) : 0;
    }
};

template <class Epi, class Sched, bool GATHER>
__device__ __forceinline__ void gemm_phase(LAS unsigned char* lds, const int wid, const bf16_t* A, int lda, const bf16_t* Bt, int ldb, size_t b_estride, int K, const Sched& S, const Epi& E) {
    const int lane = lane_id_v(), tid = wid * 64 + lane, wr = wid >> 2, wc = wid & 3, fr = lane & 15, fq = lane >> 4;
    const int nt = K / BK;
    unsigned voffA[2], voffB[2]; int RA[2], CA[2];
#pragma unroll
    for (int i = 0; i < 2; ++i) { int R, C; stage_rc(tid * 16 + i * 8192, R, C); const int Rb = Epi::PERM ? ((R & ~31) + perm32(R & 31)) : R;
        RA[i] = R; CA[i] = C; voffA[i] = (unsigned)(R * lda + C) * 2u; voffB[i] = (unsigned)(Rb * ldb + C) * 2u; }
    const size_t kstep = (size_t)(BK * 2);
    const size_t hstepA = (size_t)HALF * lda * 2, hstepB = (size_t)HALF * ldb * 2;
    const size_t tstepA = 2 * hstepA, tstepB = 2 * hstepB;
    const unsigned ldsw = (unsigned)wid * 1024u;
    const int aoff = lds_byte(wr * 64 + fr, fq * 8), boff = lds_byte(wc * 32 + fr, fq * 8);
#define PG8_SA(b, h) (((b) * 2 + (h)) * HTB)
#define PG8_SB(b, h) ((4 + (b) * 2 + (h)) * HTB)
#define PG8_STAGE(bufoff, gbase, voff) do { _Pragma("unroll") for (int _i = 0; _i < 2; ++_i) \
        __builtin_amdgcn_global_load_lds((const unsigned*)((const char*)(gbase) + (voff)[_i]), (LAS unsigned*)(lds + (bufoff) + ldsw + _i * 8192), 16, 0, 0); } while (0)
#define PG8_LDA(dst, b, h) do { _Pragma("unroll") for (int m = 0; m < 4; ++m) _Pragma("unroll") for (int k = 0; k < 2; ++k) dst[m][k] = *(const LAS bf16x8*)(lds + PG8_SA(b, h) + aoff + m * 2048 + k * 1024); } while (0)
#define PG8_LDB(dst, b, h) do { _Pragma("unroll") for (int n = 0; n < 2; ++n) _Pragma("unroll") for (int k = 0; k < 2; ++k) dst[n][k] = *(const LAS bf16x8*)(lds + PG8_SB(b, h) + boff + n * 2048 + k * 1024); } while (0)
#define PG8_MMA(ai, bj, At, Bt_) do { __builtin_amdgcn_s_setprio(1); _Pragma("unroll") for (int m = 0; m < 4; ++m) _Pragma("unroll") for (int n = 0; n < 2; ++n) _Pragma("unroll") for (int k = 0; k < 2; ++k) \
        acc[ai][bj][m][n] = __builtin_amdgcn_mfma_f32_16x16x32_bf16(Bt_[n][k], At[m][k], acc[ai][bj][m][n], 0, 0, 0); __builtin_amdgcn_s_setprio(0); } while (0)
#define PG8_WAIT_V(n) asm volatile("s_waitcnt vmcnt(" #n ")" ::: "memory")
#define PG8_WAIT_L(n) asm volatile("s_waitcnt lgkmcnt(" #n ")" ::: "memory")
#define PG8_BAR __builtin_amdgcn_s_barrier()
#define PG8_SCHED __builtin_amdgcn_sched_barrier(0)
#define PG8_STAGE_A(bufoff, ptr_dense, half, ktoff, goffs) do { if constexpr (GATHER) { PG8_STAGE(bufoff, (const char*)A + (ktoff), goffs); } \
        else { PG8_STAGE(bufoff, (ptr_dense) + (half) * hstepA, voffA); } } while (0)
    Unit cur, nxt; int ui = 0;
    if (!S.next(0, cur)) return;
    f32x4 acc[2][2][4][2];
#pragma unroll
    for (int a = 0; a < 2; ++a)
#pragma unroll
        for (int b = 0; b < 2; ++b)
#pragma unroll
            for (int m = 0; m < 4; ++m)
#pragma unroll
                for (int n = 0; n < 2; ++n) acc[a][b][m][n] = (f32x4){0.f, 0.f, 0.f, 0.f};
    bf16x8 At[4][2], B0[2][2], B1[2][2];
    unsigned gc0[2] = {0u, 0u}, gc1[2] = {0u, 0u}, gn0[2] = {0u, 0u}, gn1[2] = {0u, 0u};
    if constexpr (GATHER) {
#pragma unroll
        for (int i = 0; i < 2; ++i) { gc0[i] = (unsigned)(S.gather(cur, RA[i]) * lda + CA[i]) * 2u; gc1[i] = (unsigned)(S.gather(cur, 128 + RA[i]) * lda + CA[i]) * 2u; }
    }
    const char* cA = (const char*)A + (size_t)cur.pm * tstepA; const char* cB = (const char*)Bt + ((size_t)cur.e * b_estride) * 2 + (size_t)cur.pn * tstepB;
    PG8_STAGE(PG8_SB(0, 0), cB, voffB); PG8_STAGE(PG8_SB(0, 1), cB + hstepB, voffB); PG8_STAGE_A(PG8_SA(0, 0), cA, 0, 0, gc0); PG8_STAGE_A(PG8_SA(0, 1), cA, 1, 0, gc1);
    if (wr == 1) PG8_BAR;
    PG8_WAIT_V(2); PG8_BAR;
    PG8_STAGE(PG8_SB(1, 0), cB + kstep, voffB); PG8_STAGE_A(PG8_SA(1, 0), cA + kstep, 0, kstep, gc0); PG8_STAGE(PG8_SB(1, 1), cB + hstepB + kstep, voffB);
    PG8_WAIT_V(6); PG8_BAR;
    for (;;) {
        const bool has_next = S.next(ui + 1, nxt);
        const char* nA = has_next ? (const char*)A + (size_t)nxt.pm * tstepA : cA;
        const char* nB = has_next ? (const char*)Bt + ((size_t)nxt.e * b_estride) * 2 + (size_t)nxt.pn * tstepB : cB;
        if constexpr (GATHER) {
            if (has_next) {
#pragma unroll
                for (int i = 0; i < 2; ++i) { gn0[i] = (unsigned)(S.gather(nxt, RA[i]) * lda + CA[i]) * 2u; gn1[i] = (unsigned)(S.gather(nxt, 128 + RA[i]) * lda + CA[i]) * 2u; }
            } else {
#pragma unroll
                for (int i = 0; i < 2; ++i) { gn0[i] = gc0[i]; gn1[i] = gc1[i]; }
            }
        }
        for (int t = 0; t < nt; t += 2) {
            const bool last = (t == nt - 2);
            const char* a1 = cA + (size_t)(t + 1) * kstep;
            const char* a2 = last ? nA : cA + (size_t)(t + 2) * kstep; const char* b2 = last ? nB : cB + (size_t)(t + 2) * kstep;
            const char* a3 = a2 + kstep; const char* b3 = b2 + kstep;
            const size_t k1 = (size_t)(t + 1) * kstep, k2 = last ? 0 : (size_t)(t + 2) * kstep, k3 = k2 + kstep;
            unsigned g20[2], g21[2];
#pragma unroll
            for (int i = 0; i < 2; ++i) { g20[i] = last ? gn0[i] : gc0[i]; g21[i] = last ? gn1[i] : gc1[i]; }
            PG8_LDB(B0, 0, 0); PG8_LDB(B1, 0, 1); PG8_SCHED; PG8_LDA(At, 0, 0); PG8_STAGE_A(PG8_SA(1, 1), a1, 1, k1, gc1);
            PG8_WAIT_V(8); PG8_WAIT_L(0); PG8_BAR; PG8_MMA(0, 0, At, B0); PG8_MMA(0, 1, At, B1); PG8_BAR; PG8_SCHED;
            PG8_LDA(At, 0, 1); PG8_STAGE(PG8_SB(0, 0), b2, voffB); PG8_STAGE(PG8_SB(0, 1), b2 + hstepB, voffB); PG8_STAGE_A(PG8_SA(0, 0), a2, 0, k2, g20);
            PG8_WAIT_V(8); PG8_WAIT_L(0); PG8_BAR; PG8_MMA(1, 0, At, B0); PG8_MMA(1, 1, At, B1); PG8_BAR; PG8_SCHED;
            PG8_LDB(B0, 1, 0); PG8_LDB(B1, 1, 1); PG8_SCHED; PG8_LDA(At, 1, 0); PG8_STAGE_A(PG8_SA(0, 1), a2, 1, k2, g21);
            PG8_WAIT_V(8); PG8_WAIT_L(0); PG8_BAR; PG8_MMA(0, 0, At, B0); PG8_MMA(0, 1, At, B1); PG8_BAR; PG8_SCHED;
            PG8_LDA(At, 1, 1); PG8_STAGE(PG8_SB(1, 0), b3, voffB); PG8_STAGE(PG8_SB(1, 1), b3 + hstepB, voffB); PG8_STAGE_A(PG8_SA(1, 0), a3, 0, k3, g20);
            PG8_WAIT_V(8); PG8_WAIT_L(0); PG8_BAR; PG8_MMA(1, 0, At, B0); PG8_MMA(1, 1, At, B1); PG8_BAR; PG8_SCHED;
        }
        if (wr == 0) PG8_BAR;
        E(acc, cur, wr, wc, fr, fq);
        if (!has_next) break;
#pragma unroll
        for (int a = 0; a < 2; ++a)
#pragma unroll
            for (int b = 0; b < 2; ++b)
#pragma unroll
                for (int m = 0; m < 4; ++m)
#pragma unroll
                    for (int n = 0; n < 2; ++n) acc[a][b][m][n] = (f32x4){0.f, 0.f, 0.f, 0.f};
        cur = nxt; cA = nA; cB = nB; ++ui;
        if constexpr (GATHER) {
#pragma unroll
            for (int i = 0; i < 2; ++i) { gc0[i] = gn0[i]; gc1[i] = gn1[i]; }
        }
        if (wr == 1) PG8_BAR;
    }
    PG8_WAIT_V(0);
    PG8_BAR;
#undef PG8_SA
#undef PG8_SB
#undef PG8_STAGE
#undef PG8_STAGE_A
#undef PG8_LDA
#undef PG8_LDB
#undef PG8_MMA
#undef PG8_WAIT_V
#undef PG8_WAIT_L
#undef PG8_BAR
#undef PG8_SCHED
}

typedef const f32x4 (&AccT)[2][2][4][2];
__device__ __forceinline__ u32x4 pack8(f32x4 v0, f32x4 v1) { u32x4 w; w.x = cvt_pk_bf16(v0[0], v0[1]); w.y = cvt_pk_bf16(v0[2], v0[3]); w.z = cvt_pk_bf16(v1[0], v1[1]); w.w = cvt_pk_bf16(v1[2], v1[3]); return w; }
__device__ __forceinline__ void rope8(f32x4& v0, f32x4& v1, f32x4 t0, f32x4 t1) {
    f32x4 a, b;
    a[0] = v0[0] * t0[0] - v0[1] * t0[1]; a[1] = v0[1] * t0[0] + v0[0] * t0[1]; a[2] = v0[2] * t0[2] - v0[3] * t0[3]; a[3] = v0[3] * t0[2] + v0[2] * t0[3];
    b[0] = v1[0] * t1[0] - v1[1] * t1[1]; b[1] = v1[1] * t1[0] + v1[0] * t1[1]; b[2] = v1[2] * t1[2] - v1[3] * t1[3]; b[3] = v1[3] * t1[2] + v1[2] * t1[3];
    v0 = a; v1 = b;
}
struct EpiG1 {
    static constexpr bool PERM = true;
    bf16_t *CQ, *CKV, *DQ, *DK, *DV, *KA; float *SSQQ, *SSQKV; const float* rope;
    __device__ __forceinline__ void operator()(AccT acc, const Unit& u, int wr, int wc, int, int) const {
        const int lane_ = lane_id_v(), fr = lane_ & 15, fq = lane_ >> 4;
        const int row0 = u.pm * BM + wr * 64 + fr, cw = wc * 32 + 8 * fq, pn = u.pn;
        if (pn <= 1) {
            bf16_t* dst = pn ? CKV : CQ; float* ssq = pn ? SSQKV : SSQQ;
#pragma unroll
            for (int ai = 0; ai < 2; ++ai)
#pragma unroll
                for (int m = 0; m < 4; ++m) { const int r = row0 + ai * HALF + m * 16; float s = 0.f;
#pragma unroll
                    for (int bj = 0; bj < 2; ++bj) { const f32x4 v0 = acc[ai][bj][m][0], v1 = acc[ai][bj][m][1];
                        s += (v0[0] * v0[0] + v0[1] * v0[1]) + (v0[2] * v0[2] + v0[3] * v0[3]) + (v1[0] * v1[0] + v1[1] * v1[1]) + (v1[2] * v1[2] + v1[3] * v1[3]);
                        *(u32x4*)(dst + (size_t)r * 256 + bj * HALF + cw) = pack8(v0, v1); }
                    s += __shfl_xor(s, 16); s += __shfl_xor(s, 32);
                    if (fq == 0) ssq[(size_t)r * 4 + wc] = s; }
        } else if (pn <= 5) {
            bf16_t* dst = (pn <= 3) ? DQ : DK; const int cbase = ((pn - 2) & 1) * 256; const int p0 = 16 * (wc & 1) + 4 * fq; const float qs = (pn <= 3) ? QSC_DIFF : 1.0f;
#pragma unroll
            for (int ai = 0; ai < 2; ++ai)
#pragma unroll
                for (int m = 0; m < 4; ++m) { const int r = row0 + ai * HALF + m * 16; const int pos = r & (SEQ - 1);
                    const f32x4 t0 = *(const f32x4*)(rope + ((size_t)pos * 32 + p0) * 2), t1 = *(const f32x4*)(rope + ((size_t)pos * 32 + p0 + 2) * 2);
#pragma unroll
                    for (int bj = 0; bj < 2; ++bj) { f32x4 v0 = acc[ai][bj][m][0] * qs, v1 = acc[ai][bj][m][1] * qs; rope8(v0, v1, t0, t1);
                        *(u32x4*)(dst + (size_t)r * 512 + cbase + bj * HALF + cw) = pack8(v0, v1); } }
        } else if (pn <= 7) {
#pragma unroll
            for (int ai = 0; ai < 2; ++ai)
#pragma unroll
                for (int m = 0; m < 4; ++m) { const int r = row0 + ai * HALF + m * 16;
#pragma unroll
                    for (int bj = 0; bj < 2; ++bj) *(u32x4*)(DV + (size_t)r * 512 + (pn - 6) * 256 + bj * HALF + cw) = pack8(acc[ai][bj][m][0], acc[ai][bj][m][1]); }
        } else {
            if (wc < 2) { const int p0 = 16 * wc + 4 * fq;
#pragma unroll
                for (int ai = 0; ai < 2; ++ai)
#pragma unroll
                    for (int m = 0; m < 4; ++m) { const int r = row0 + ai * HALF + m * 16; const int pos = r & (SEQ - 1);
                        const f32x4 t0 = *(const f32x4*)(rope + ((size_t)pos * 32 + p0) * 2), t1 = *(const f32x4*)(rope + ((size_t)pos * 32 + p0 + 2) * 2);
                        f32x4 v0 = acc[ai][0][m][0], v1 = acc[ai][0][m][1]; rope8(v0, v1, t0, t1); const u32x4 w = pack8(v0, v1);
#pragma unroll
                        for (int h = 0; h < 4; ++h) *(u32x4*)(KA + (size_t)r * 768 + h * 192 + 128 + cw) = w; } }
        }
    }
};
struct EpiQ {
    static constexpr bool PERM = true;
    bf16_t* QA; const float* SSQQ; const float* rope;
    __device__ __forceinline__ void operator()(AccT acc, const Unit& u, int wr, int wc, int, int) const {
        const int lane_ = lane_id_v(), fr = lane_ & 15, fq = lane_ >> 4;
        const int row0 = u.pm * BM + wr * 64 + fr;
#pragma unroll
        for (int ai = 0; ai < 2; ++ai)
#pragma unroll
            for (int m = 0; m < 4; ++m) { const int r = row0 + ai * HALF + m * 16; const int pos = r & (SEQ - 1);
                const f32x4 ss = *(const f32x4*)(SSQQ + (size_t)r * 4); const float rstd = 1.0f / sqrtf(((ss[0] + ss[1]) + (ss[2] + ss[3])) * (1.0f / 256.0f) + EPS);
#pragma unroll
                for (int bj = 0; bj < 2; ++bj) { const int colt = u.pn * BM + bj * HALF + wc * 32; const int w = colt % 192; const int col = colt + 8 * fq;
                    f32x4 v0 = acc[ai][bj][m][0] * (rstd * QSC_MLA), v1 = acc[ai][bj][m][1] * (rstd * QSC_MLA);
                    if (w >= 128) { const int p0 = (w - 128 + 8 * fq) >> 1;
                        const f32x4 t0 = *(const f32x4*)(rope + ((size_t)pos * 32 + p0) * 2), t1 = *(const f32x4*)(rope + ((size_t)pos * 32 + p0 + 2) * 2); rope8(v0, v1, t0, t1); }
                    *(u32x4*)(QA + (size_t)r * 768 + col) = pack8(v0, v1); } }
    }
};
struct EpiKV {
    static constexpr bool PERM = true;
    bf16_t *KA, *VA; const float* SSQKV;
    __device__ __forceinline__ void operator()(AccT acc, const Unit& u, int wr, int wc, int, int) const {
        const int lane_ = lane_id_v(), fr = lane_ & 15, fq = lane_ >> 4;
        const int row0 = u.pm * BM + wr * 64 + fr, cw = wc * 32 + 8 * fq, h = u.pn;
#pragma unroll
        for (int ai = 0; ai < 2; ++ai)
#pragma unroll
            for (int m = 0; m < 4; ++m) { const int r = row0 + ai * HALF + m * 16;
                const f32x4 ss = *(const f32x4*)(SSQKV + (size_t)r * 4); const float rstd = 1.0f / sqrtf(((ss[0] + ss[1]) + (ss[2] + ss[3])) * (1.0f / 256.0f) + EPS);
                *(u32x4*)(KA + (size_t)r * 768 + h * 192 + cw) = pack8(acc[ai][0][m][0] * rstd, acc[ai][0][m][1] * rstd);
                *(u32x4*)(VA + (size_t)r * 512 + h * 128 + cw) = pack8(acc[ai][1][m][0] * rstd, acc[ai][1][m][1] * rstd); }
    }
};
struct EpiX1 {
    static constexpr bool PERM = false;
    const float* x; float* x1; const float* mod;
    __device__ __forceinline__ void operator()(AccT acc, const Unit& u, int wr, int wc, int, int) const {
        const int lane_ = lane_id_v(), fr = lane_ & 15, fq = lane_ >> 4;
        const int row0 = u.pm * BM + wr * 64 + fr, col0 = u.pn * BM + wc * 32 + 4 * fq, b = u.pm >> 5;
        f32x4 g[2][2];
#pragma unroll
        for (int bj = 0; bj < 2; ++bj)
#pragma unroll
            for (int n = 0; n < 2; ++n) g[bj][n] = *(const f32x4*)(mod + (size_t)(b * 6 + 2) * DM + col0 + bj * HALF + n * 16);
#pragma unroll
        for (int ai = 0; ai < 2; ++ai)
#pragma unroll
            for (int m = 0; m < 4; ++m) { const size_t off = (size_t)(row0 + ai * HALF + m * 16) * DM + col0;
#pragma unroll
                for (int bj = 0; bj < 2; ++bj)
#pragma unroll
                    for (int n = 0; n < 2; ++n) { const f32x4 xv = *(const f32x4*)(x + off + bj * HALF + n * 16); *(f32x4*)(x1 + off + bj * HALF + n * 16) = xv + g[bj][n] * acc[ai][bj][m][n]; } }
    }
};
__device__ __forceinline__ float silu_mul(float g, float u) { return g * u * __builtin_amdgcn_rcpf(1.0f + __builtin_amdgcn_exp2f(-1.4426950408889634f * g)); }
struct EpiAct {
    static constexpr bool PERM = true;
    bf16_t* ACT;
    __device__ __forceinline__ void operator()(AccT acc, const Unit& u, int wr, int wc, int, int) const {
        const int lane_ = lane_id_v(), fr = lane_ & 15, fq = lane_ >> 4;
        const int row0 = u.pm * BM + wr * 64 + fr, col = u.pn * 128 + wc * 32 + 8 * fq;
#pragma unroll
        for (int ai = 0; ai < 2; ++ai)
#pragma unroll
            for (int m = 0; m < 4; ++m) { const int r = row0 + ai * HALF + m * 16; f32x4 a0, a1;
#pragma unroll
                for (int q = 0; q < 4; ++q) { a0[q] = silu_mul(acc[ai][0][m][0][q], acc[ai][1][m][0][q]); a1[q] = silu_mul(acc[ai][0][m][1][q], acc[ai][1][m][1][q]); }
                *(u32x4*)(ACT + (size_t)r * DEXP + col) = pack8(a0, a1); }
    }
};
struct EpiDown {
    static constexpr bool PERM = true;
    bf16_t* Y; const int* list; const float* listw;
    __device__ __forceinline__ void operator()(AccT acc, const Unit& u, int wr, int wc, int, int) const {
        const int lane_ = lane_id_v(), fr = lane_ & 15, fq = lane_ >> 4;
        const int cw = u.pn * BM + wc * 32 + 8 * fq;
#pragma unroll
        for (int ai = 0; ai < 2; ++ai)
#pragma unroll
            for (int m = 0; m < 4; ++m) { const int idx = u.t * 256 + ai * HALF + wr * 64 + m * 16 + fr;
                if (idx < u.cnt) { const int ent = list[u.e * LCAP + idx]; const float w = listw[u.e * LCAP + idx];
#pragma unroll
                    for (int bj = 0; bj < 2; ++bj) *(u32x4*)(Y + (size_t)ent * DM + cw + bj * HALF) = pack8(acc[ai][bj][m][0] * w, acc[ai][bj][m][1] * w); } }
    }
};
}

namespace att {
constexpr int NW = 8, QBLK = 32, KVBLK = 64, DV = 128;
constexpr float THR = 8.f;
#define SBAR() __builtin_amdgcn_sched_barrier(0)
__device__ __forceinline__ int crow(int r, int hi) { return (r & 3) + 8 * (r >> 2) + 4 * hi; }
__device__ __forceinline__ unsigned cvtpk(float lo, float hi) { unsigned r; asm volatile("v_cvt_pk_bf16_f32 %0, %1, %2" : "=v"(r) : "v"(lo), "v"(hi)); return r; }
__device__ __forceinline__ int kg(int row) { return (row >> 1) & 7; }
template <int DQK> __device__ __forceinline__ int kswz(int row, int colB) { return row * (DQK * 2) + (colB ^ (kg(row) << 4)); }
template <int DQK> struct Sc { static constexpr float SCALE = (DQK == 192) ? 0.07216878364870322f : 0.125f; };

__device__ __forceinline__ int v_st(int k, int c) { const int kk = (k & ~0xC) | ((k & 4) << 1) | ((k & 8) >> 1); return ((kk >> 3) * 4 + (c >> 5)) * 512 + ((kk & 7) * 32 + (c & 31)) * 2; }
__device__ __forceinline__ int v_rd_base(int lane) { return ((lane & 3) << 3) | (((lane >> 2) & 3) << 6) | (((lane >> 4) & 1) << 5) | (((lane >> 5) & 1) << 8); }
constexpr int v_rd_off(int d0, int ks, int half) { return d0 * 512 + ks * 4096 + half * 2048; }
__device__ __forceinline__ void glds16(const void* gsrc, LAS unsigned* dst) { __builtin_amdgcn_global_load_lds((const unsigned*)gsrc, dst, 16, 0, 0); }
template <int OFF> __device__ __forceinline__ void dsr128(bf16x8& d, int addr) { asm volatile("ds_read_b128 %0, %1 offset:%2" : "=v"(d) : "v"(addr), "i"(OFF)); }
template <int OFF> __device__ __forceinline__ void dstr64(s16x4& d, int addr) { asm volatile("ds_read_b64_tr_b16 %0, %1 offset:%2" : "=v"(d) : "v"(addr), "i"(OFF)); }
#define LW2(N, a, b) asm volatile("s_waitcnt lgkmcnt(" #N ")" : "+v"(a), "+v"(b))
#define LW8(N, a) asm volatile("s_waitcnt lgkmcnt(" #N ")" : "+v"(a[0]), "+v"(a[1]), "+v"(a[2]), "+v"(a[3]), "+v"(a[4]), "+v"(a[5]), "+v"(a[6]), "+v"(a[7]))
#define BAR_ALL() asm volatile("s_waitcnt lgkmcnt(0)\n\ts_barrier" ::: "memory")


constexpr float THRL = 8.f;
__device__ __forceinline__ void smax_tile(f32x16& p0, f32x16& p1, float& mhat, float& l_reg, f32x16 (&o)[4], float* al_l, const bool first, int r32, int hi,
                                          bf16x8& pa0, bf16x8& pa1, bf16x8& pa2, bf16x8& pa3) {
    float a = fmaxf(fmaxf(p0[0], p0[1]), p1[0]), b = fmaxf(fmaxf(p0[2], p0[3]), p1[1]); a = fmaxf(fmaxf(a, p1[2]), p1[3]);
#pragma unroll
    for (int r = 4; r < 16; r += 4) { a = fmaxf(fmaxf(a, p0[r]), p0[r + 1]); b = fmaxf(fmaxf(b, p0[r + 2]), p0[r + 3]); a = fmaxf(fmaxf(a, p1[r]), p1[r + 1]); b = fmaxf(fmaxf(b, p1[r + 2]), p1[r + 3]); }
    float rm = fmaxf(a, b);
    { auto rr = __builtin_amdgcn_permlane32_swap(__float_as_uint(rm), __float_as_uint(rm), false, false); rm = fmaxf(__uint_as_float(rr[0]), __uint_as_float(rr[1])); }
    if (__builtin_expect(first || __any(rm > THRL), 0)) {
        const float dl = first ? rm : fmaxf(rm, 0.f);
        mhat += dl;
#pragma unroll
        for (int r = 0; r < 16; ++r) { p0[r] -= dl; p1[r] -= dl; }
        if (!first) { const float f = __builtin_amdgcn_exp2f(-dl); l_reg *= f;
            if (hi == 0) al_l[r32] = f; asm volatile("s_waitcnt lgkmcnt(0)" ::: "memory");
#pragma unroll
            for (int d = 0; d < 4; ++d)
#pragma unroll
                for (int r = 0; r < 16; ++r) o[d][r] *= al_l[crow(r, hi)]; }
    }
#pragma unroll
    for (int r = 0; r < 16; ++r) p0[r] = __builtin_amdgcn_exp2f(p0[r]);
#pragma unroll
    for (int r = 0; r < 16; ++r) p1[r] = __builtin_amdgcn_exp2f(p1[r]);
    float ps = 0;
#pragma unroll
    for (int r = 0; r < 16; ++r) ps += p0[r];
#pragma unroll
    for (int r = 0; r < 16; ++r) ps += p1[r];
    { auto rr = __builtin_amdgcn_permlane32_swap(__float_as_uint(ps), __float_as_uint(ps), false, false); ps = __uint_as_float(rr[0]) + __uint_as_float(rr[1]); }
    l_reg += ps;
#define PK4(P, BASE, OUT) do { u32x4 w = {cvtpk(P[BASE + 0], P[BASE + 1]), cvtpk(P[BASE + 2], P[BASE + 3]), cvtpk(P[BASE + 4], P[BASE + 5]), cvtpk(P[BASE + 6], P[BASE + 7])}; \
    OUT = *reinterpret_cast<bf16x8*>(&w); } while (0)
    PK4(p0, 0, pa0); PK4(p0, 8, pa1); PK4(p1, 0, pa2); PK4(p1, 8, pa3);
#undef PK4
}
template <int DQK, int D, int XP = 0> __device__ __forceinline__ void krd(bf16x8& f0, bf16x8& f1, const int (&ka_)[4]) {
    if constexpr (XP & 8) { asm volatile("" : "=v"(f0), "=v"(f1)); } else {
    dsr128<(D >> 2) * 128>(f0, ka_[D & 3]); dsr128<(D >> 2) * 128 + 32 * DQK * 2>(f1, ka_[D & 3]); } }
template <int KS, int XP = 0> __device__ __forceinline__ void vrd(s16x4 (&v)[8], int vb_) {
    if constexpr (XP & 8) { asm volatile("" : "=v"(v[0]), "=v"(v[1]), "=v"(v[2]), "=v"(v[3]), "=v"(v[4]), "=v"(v[5]), "=v"(v[6]), "=v"(v[7])); return; }
    dstr64<v_rd_off(0, KS, 0)>(v[0], vb_); dstr64<v_rd_off(0, KS, 1)>(v[1], vb_); dstr64<v_rd_off(1, KS, 0)>(v[2], vb_); dstr64<v_rd_off(1, KS, 1)>(v[3], vb_);
    dstr64<v_rd_off(2, KS, 0)>(v[4], vb_); dstr64<v_rd_off(2, KS, 1)>(v[5], vb_); dstr64<v_rd_off(3, KS, 0)>(v[6], vb_); dstr64<v_rd_off(3, KS, 1)>(v[7], vb_); }
#define PKV(L, H) (bf16x8){L[0], L[1], L[2], L[3], H[0], H[1], H[2], H[3]}
__device__ __forceinline__ void pvmma(f32x16 (&o)[4], const s16x4 (&v)[8], bf16x8 pa) {
    o[0] = __builtin_amdgcn_mfma_f32_32x32x16_bf16(pa, PKV(v[0], v[1]), o[0], 0, 0, 0); o[1] = __builtin_amdgcn_mfma_f32_32x32x16_bf16(pa, PKV(v[2], v[3]), o[1], 0, 0, 0);
    o[2] = __builtin_amdgcn_mfma_f32_32x32x16_bf16(pa, PKV(v[4], v[5]), o[2], 0, 0, 0); o[3] = __builtin_amdgcn_mfma_f32_32x32x16_bf16(pa, PKV(v[6], v[7]), o[3], 0, 0, 0); }
#undef PKV
template <int DQK, bool HASPV, int D0, int XP = 0>
__device__ __forceinline__ void qk_step(bf16x8 (&kf)[DQK / 16][2], s16x4 (&vf0)[8], const int (&ka_)[4], int vb_, const bf16x8* qr, f32x16& p0, f32x16& p1, const float nm) {
    constexpr int NQ = DQK / 16;
    if constexpr (D0 + 2 < NQ) krd<DQK, D0 + 2, XP>(kf[D0 + 2][0], kf[D0 + 2][1], ka_);
    if constexpr (HASPV && D0 == NQ - 2) vrd<0, XP>(vf0, vb_);
    if constexpr (D0 + 2 < NQ) LW2(4, kf[D0][0], kf[D0][1]);
    else if constexpr (D0 == NQ - 2) { if constexpr (HASPV) LW2(10, kf[D0][0], kf[D0][1]); else LW2(2, kf[D0][0], kf[D0][1]); }
    else { if constexpr (HASPV) LW2(8, kf[D0][0], kf[D0][1]); else LW2(0, kf[D0][0], kf[D0][1]); }
    SBAR();
    if constexpr (D0 == 0) { f32x16 negm;
#pragma unroll
        for (int r = 0; r < 16; ++r) negm[r] = nm;
        p0 = __builtin_amdgcn_mfma_f32_32x32x16_bf16(kf[D0][0], qr[D0], negm, 0, 0, 0); p1 = __builtin_amdgcn_mfma_f32_32x32x16_bf16(kf[D0][1], qr[D0], negm, 0, 0, 0); }
    else { p0 = __builtin_amdgcn_mfma_f32_32x32x16_bf16(kf[D0][0], qr[D0], p0, 0, 0, 0); p1 = __builtin_amdgcn_mfma_f32_32x32x16_bf16(kf[D0][1], qr[D0], p1, 0, 0, 0); }
    SBAR();
    if constexpr (D0 + 1 < NQ) qk_step<DQK, HASPV, D0 + 1, XP>(kf, vf0, ka_, vb_, qr, p0, p1, nm);
}
template <int DQK, bool HASQK, bool HASPV, int XP = 0>
__device__ __forceinline__ void seg_m(const int (&ka_)[4], int vb_, const bf16x8* qr, f32x16& p0, f32x16& p1, const float nm, f32x16 (&o)[4], bf16x8 pa0, bf16x8 pa1, bf16x8 pa2, bf16x8 pa3) {
    constexpr int NQ = DQK / 16;
    bf16x8 kf[NQ][2]; s16x4 vf[4][8];
    if constexpr (HASQK) { krd<DQK, 0, XP>(kf[0][0], kf[0][1], ka_); krd<DQK, 1, XP>(kf[1][0], kf[1][1], ka_);
        qk_step<DQK, HASPV, 0, XP>(kf, vf[0], ka_, vb_, qr, p0, p1, nm); }
    else if constexpr (HASPV) vrd<0, XP>(vf[0], vb_);
    if constexpr (HASPV) {
        vrd<1, XP>(vf[1], vb_); LW8(8, vf[0]); SBAR(); pvmma(o, vf[0], pa0); SBAR();
        vrd<2, XP>(vf[2], vb_); LW8(8, vf[1]); SBAR(); pvmma(o, vf[1], pa1); SBAR();
        vrd<3, XP>(vf[3], vb_); LW8(8, vf[2]); SBAR(); pvmma(o, vf[2], pa2); SBAR();
        LW8(0, vf[3]); SBAR(); pvmma(o, vf[3], pa3); SBAR(); }
}

#define LW1(N, a) asm volatile("s_waitcnt lgkmcnt(" #N ")" : "+v"(a))
template <int DQK, bool HASQK, bool HASPV, int J>
__device__ __forceinline__ void slot_read(bf16x8 (&kf)[DQK / 16][2], s16x4 (&vf)[4][8], const int (&ka_)[4], int vb_) {
    constexpr int NQS = HASQK ? 2 * (DQK / 16) : 0, NS = NQS + (HASPV ? 16 : 0);
    if constexpr (J < NQS) { constexpr int d0 = J >> 1, h = J & 1; dsr128<(d0 >> 2) * 128 + h * 32 * DQK * 2>(kf[d0][h], ka_[d0 & 3]); }
    else if constexpr (J < NS) { constexpr int q = J - NQS, g = q >> 2, d = q & 3; dstr64<v_rd_off(d, g, 0)>(vf[g][2 * d], vb_); dstr64<v_rd_off(d, g, 1)>(vf[g][2 * d + 1], vb_); }
}
template <int DQK, bool HASQK, bool HASPV, int J>
__device__ __forceinline__ void slot_run(bf16x8 (&kf)[DQK / 16][2], s16x4 (&vf)[4][8], const int (&ka_)[4], int vb_, const bf16x8* qr, f32x16& p0, f32x16& p1, const f32x16& negm,
                                         f32x16 (&o)[4], const bf16x8 (&pa)[4]) {
    constexpr int NQS = HASQK ? 2 * (DQK / 16) : 0, NS = NQS + (HASPV ? 16 : 0);
    if constexpr (J < NS) {
        constexpr int rd1 = (J + 1 < NS) ? ((J + 1 < NQS) ? 1 : 2) : 0, rd2 = (J + 2 < NS) ? ((J + 2 < NQS) ? 1 : 2) : 0, rd3 = (J + 3 < NS) ? ((J + 3 < NQS) ? 1 : 2) : 0, NW = rd1 + rd2 + rd3;
#define LWN1(a) do { if constexpr (NW == 0) LW1(0, a); else if constexpr (NW == 1) LW1(1, a); else if constexpr (NW == 2) LW1(2, a); else if constexpr (NW == 3) LW1(3, a); else if constexpr (NW == 4) LW1(4, a); else if constexpr (NW == 5) LW1(5, a); else LW1(6, a); } while (0)
#define LWN2(a, b) do { if constexpr (NW == 0) LW2(0, a, b); else if constexpr (NW == 1) LW2(1, a, b); else if constexpr (NW == 2) LW2(2, a, b); else if constexpr (NW == 3) LW2(3, a, b); else if constexpr (NW == 4) LW2(4, a, b); else if constexpr (NW == 5) LW2(5, a, b); else LW2(6, a, b); } while (0)
        if constexpr (J < NQS) { constexpr int d0 = J >> 1, h = J & 1;
            LWN1(kf[d0][h]); SBAR();
            if constexpr (h == 0) p0 = __builtin_amdgcn_mfma_f32_32x32x16_bf16(kf[d0][0], qr[d0], (d0 == 0) ? negm : p0, 0, 0, 0);
            else p1 = __builtin_amdgcn_mfma_f32_32x32x16_bf16(kf[d0][1], qr[d0], (d0 == 0) ? negm : p1, 0, 0, 0);
        } else { constexpr int q = J - NQS, g = q >> 2, d = q & 3;
            LWN2(vf[g][2 * d], vf[g][2 * d + 1]); SBAR();
            o[d] = __builtin_amdgcn_mfma_f32_32x32x16_bf16(pa[g], (bf16x8){vf[g][2 * d][0], vf[g][2 * d][1], vf[g][2 * d][2], vf[g][2 * d][3], vf[g][2 * d + 1][0], vf[g][2 * d + 1][1], vf[g][2 * d + 1][2], vf[g][2 * d + 1][3]}, o[d], 0, 0, 0);
        }
#undef LWN1
#undef LWN2
        SBAR();
        slot_read<DQK, HASQK, HASPV, J + 4>(kf, vf, ka_, vb_);
        SBAR();
        slot_run<DQK, HASQK, HASPV, J + 1>(kf, vf, ka_, vb_, qr, p0, p1, negm, o, pa);
    }
}
#define LW3(N, a, b, c) asm volatile("s_waitcnt lgkmcnt(" #N ")" : "+v"(a), "+v"(b), "+v"(c))
#define LW4(N, a, b, c, d) asm volatile("s_waitcnt lgkmcnt(" #N ")" : "+v"(a), "+v"(b), "+v"(c), "+v"(d))
template <int DQK, bool HASQK, bool HASPV, int J>
__device__ __forceinline__ void slot_mma(bf16x8 (&kf)[DQK / 16][2], s16x4 (&vf)[4][8], const bf16x8* qr, f32x16& p0, f32x16& p1, const f32x16& negm, f32x16 (&o)[4], const bf16x8 (&pa)[4]) {
    constexpr int NQS = HASQK ? 2 * (DQK / 16) : 0;
    if constexpr (J < NQS) { constexpr int d0 = J >> 1, h = J & 1;
        if constexpr (h == 0) p0 = __builtin_amdgcn_mfma_f32_32x32x16_bf16(kf[d0][0], qr[d0], (d0 == 0) ? negm : p0, 0, 0, 0);
        else p1 = __builtin_amdgcn_mfma_f32_32x32x16_bf16(kf[d0][1], qr[d0], (d0 == 0) ? negm : p1, 0, 0, 0);
    } else { constexpr int q = J - NQS, g = q >> 2, d = q & 3;
        o[d] = __builtin_amdgcn_mfma_f32_32x32x16_bf16(pa[g], (bf16x8){vf[g][2 * d][0], vf[g][2 * d][1], vf[g][2 * d][2], vf[g][2 * d][3], vf[g][2 * d + 1][0], vf[g][2 * d + 1][1], vf[g][2 * d + 1][2], vf[g][2 * d + 1][3]}, o[d], 0, 0, 0); }
}
template <int DQK, bool HASQK, bool HASPV, int J>
__device__ __forceinline__ void slot_run2(bf16x8 (&kf)[DQK / 16][2], s16x4 (&vf)[4][8], const int (&ka_)[4], int vb_, const bf16x8* qr, f32x16& p0, f32x16& p1, const f32x16& negm,
                                          f32x16 (&o)[4], const bf16x8 (&pa)[4]) {
    constexpr int NQS = HASQK ? 2 * (DQK / 16) : 0, NS = NQS + (HASPV ? 16 : 0);
    if constexpr (J < NS) {
        constexpr int rd2 = (J + 2 < NS) ? ((J + 2 < NQS) ? 1 : 2) : 0, rd3 = (J + 3 < NS) ? ((J + 3 < NQS) ? 1 : 2) : 0, NW = rd2 + rd3;
#define WCASE(MAC, ...) do { if constexpr (NW == 0) MAC(0, __VA_ARGS__); else if constexpr (NW == 1) MAC(1, __VA_ARGS__); else if constexpr (NW == 2) MAC(2, __VA_ARGS__); else if constexpr (NW == 3) MAC(3, __VA_ARGS__); else MAC(4, __VA_ARGS__); } while (0)
        if constexpr (J + 1 < NQS) { WCASE(LW2, kf[J >> 1][0], kf[J >> 1][1]); }
        else if constexpr (J >= NQS) { constexpr int q = J - NQS, g = q >> 2, d = q & 3; WCASE(LW4, vf[g][2 * d], vf[g][2 * d + 1], vf[g][2 * d + 2], vf[g][2 * d + 3]); }
#undef WCASE
        SBAR();
        slot_mma<DQK, HASQK, HASPV, J>(kf, vf, qr, p0, p1, negm, o, pa); SBAR();
        slot_read<DQK, HASQK, HASPV, J + 4>(kf, vf, ka_, vb_); SBAR();
        slot_mma<DQK, HASQK, HASPV, J + 1>(kf, vf, qr, p0, p1, negm, o, pa); SBAR();
        slot_read<DQK, HASQK, HASPV, J + 5>(kf, vf, ka_, vb_); SBAR();
        slot_run2<DQK, HASQK, HASPV, J + 2>(kf, vf, ka_, vb_, qr, p0, p1, negm, o, pa);
    }
}
template <int DQK, bool HASQK, bool HASPV>
__device__ __forceinline__ void seg_m2(const int (&ka_)[4], int vb_, const bf16x8* qr, f32x16& p0, f32x16& p1, const float nm, f32x16 (&o)[4], bf16x8 pa0, bf16x8 pa1, bf16x8 pa2, bf16x8 pa3) {
    bf16x8 kf[DQK / 16][2]; s16x4 vf[4][8]; const bf16x8 pa[4] = {pa0, pa1, pa2, pa3};
    slot_read<DQK, HASQK, HASPV, 0>(kf, vf, ka_, vb_); slot_read<DQK, HASQK, HASPV, 1>(kf, vf, ka_, vb_); slot_read<DQK, HASQK, HASPV, 2>(kf, vf, ka_, vb_); slot_read<DQK, HASQK, HASPV, 3>(kf, vf, ka_, vb_);
    SBAR();
    f32x16 negm;
#pragma unroll
    for (int r = 0; r < 16; ++r) negm[r] = nm;
    asm volatile("" : "+v"(negm));
    SBAR();
    if constexpr (ATT_SLOTS == 2) slot_run2<DQK, HASQK, HASPV, 0>(kf, vf, ka_, vb_, qr, p0, p1, negm, o, pa);
    else slot_run<DQK, HASQK, HASPV, 0>(kf, vf, ka_, vb_, qr, p0, p1, negm, o, pa);
}
#undef LW1
#undef LW3
#undef LW4
template <int DQK, int LDQ, int LDK, int LDV, int XP = 0, bool DMA_M = false>
__device__ __forceinline__ void attn_core2(const bf16_t* __restrict__ Qb, const bf16_t* __restrict__ Kh, const bf16_t* __restrict__ Vh, char* lds, const int wid, f32x16 (&o)[4], float (&rli)[16]) {
    constexpr int SHM_V = KVBLK * DV * 2, SHM_K = KVBLK * DQK * 2, NQ = DQK / 16, CPR = DQK / 8, NKW = DQK / 64, NT = SEQ / KVBLK, RB = DQK * 2;
    const int lane = lane_id_v(), r32 = lane & 31, hi = lane >> 5; int g = wid >> 2; asm volatile("" : "+s"(g));
    char* V_lds = lds + 3 * SHM_K;
    LAS unsigned char* ldsL = (LAS unsigned char*)lds;
    float* ws = (float*)(lds + 3 * SHM_K + 3 * SHM_V) + wid * 64; float* li_l = ws; float* al_l = ws + 32;
    unsigned koff[NKW], voff[2];
#pragma unroll
    for (int j = 0; j < NKW; ++j) { const int slot = (wid * NKW + j) * 64 + lane, row = slot / CPR, ph = slot % CPR, lc = ph ^ kg(row); koff[j] = (unsigned)(row * LDK + lc * 8) * 2u; }
#pragma unroll
    for (int j = 0; j < 2; ++j) { const int off = (wid * 2 + j) * 1024 + lane * 16, st = off >> 9, o2 = off & 511, kk = (st >> 2) * 8 + (o2 >> 6);
        const int k = kk, c = (st & 3) * 32 + ((o2 & 63) >> 1); voff[j] = (unsigned)(k * LDV + c) * 2u; }
#define DMA_K(tile, b) do { _Pragma("unroll") for (int _j = 0; _j < NKW; ++_j) glds16((const char*)Kh + (size_t)(tile) * (KVBLK * LDK * 2) + koff[_j], (LAS unsigned*)(ldsL + (b) * SHM_K + (wid * NKW + _j) * 1024)); } while (0)
#define DMA_V(tile, b) do { _Pragma("unroll") for (int _j = 0; _j < 2; ++_j) glds16((const char*)Vh + (size_t)(tile) * (KVBLK * LDV * 2) + voff[_j], (LAS unsigned*)(ldsL + 3 * SHM_K + (b) * SHM_V + (wid * 2 + _j) * 1024)); } while (0)
    DMA_K(0, 0); DMA_K(1, 1); DMA_V(0, 0);
    float mhat = 0.f, l_reg = 0; bf16x8 qr[NQ];
#pragma unroll
    for (int d = 0; d < 4; ++d) o[d] = f32x16{};
    const bf16_t* Qw = Qb + (long)((wid * QBLK + r32) * LDQ + hi * 8);
#pragma unroll
    for (int d0 = 0; d0 < NQ; ++d0) qr[d0] = *reinterpret_cast<const bf16x8*>(Qw + d0 * 16);
    const int vb0 = (int)(uintptr_t)V_lds + v_rd_base(lane);
    int ka[4];
#pragma unroll
    for (int b = 0; b < 4; ++b) ka[b] = (int)(uintptr_t)lds + r32 * RB + ((b * 32 + hi * 16) ^ (kg(r32) << 4));
    f32x16 p0, p1; bf16x8 pa0, pa1, pa2, pa3;
    asm volatile("s_waitcnt vmcnt(0)" ::: "memory"); BAR_ALL();
    if (ATT_SKEW && g == 1) BAR_ALL();
#define SEG_M(HASQK, HASPV, kc, vc) do { int ka_[4]; const int vb_ = vb0 + (vc) * (int)SHM_V;                                                          \
        _Pragma("unroll") for (int b_ = 0; b_ < 4; ++b_) ka_[b_] = ka[b_] + (kc) * (int)SHM_K;                                                                     \
        if constexpr (XP == 0 && ATT_SLOTS) seg_m2<DQK, HASQK, HASPV>(ka_, vb_, qr, p0, p1, -mhat, o, pa0, pa1, pa2, pa3); else seg_m<DQK, HASQK, HASPV, XP>(ka_, vb_, qr, p0, p1, -mhat, o, pa0, pa1, pa2, pa3); } while (0)
#define SEG_S(i) do { const int cn_ = (ci == 2) ? 0 : ci + 1, cp_ = (ci == 0) ? 2 : ci - 1;                                              \
        if (!(XP & 4) && !DMA_M) { if ((i) + 2 < NT) DMA_K((i) + 2, cp_); if ((i) + 1 < NT) DMA_V((i) + 1, cn_); } SBAR();                \
        if (ATT_PRIO) __builtin_amdgcn_s_setprio(ATT_PRIO); smax_tile(p0, p1, mhat, l_reg, o, al_l, (i) == 0, r32, hi, pa0, pa1, pa2, pa3); ci = cn_;                                       \
        asm volatile("" : "+v"(l_reg), "+v"(pa0), "+v"(pa1), "+v"(pa2), "+v"(pa3));     \
        if (ATT_PRIO) __builtin_amdgcn_s_setprio(0); BAR_ALL(); } while (0)
    int ci = 0;
    if (DMA_M) { DMA_K(2, 2); DMA_V(1, 1); }
    SEG_M(true, false, 0, 0); BAR_ALL();
#pragma nounroll
    for (int i = 0; i < NT - 1; ++i) {
        SEG_S(i);
        { const int cp = (ci == 0) ? 2 : ci - 1, cn = (ci == 2) ? 0 : ci + 1;
          if (DMA_M) { if (i + 3 < NT) DMA_K(i + 3, cp); if (i + 2 < NT) DMA_V(i + 2, cn); }
          SEG_M(true, true, ci, cp);
          if (DMA_M && i + 3 < NT) asm volatile("s_waitcnt vmcnt(%0)" :: "n"(NKW + 2) : "memory");
          else asm volatile("s_waitcnt vmcnt(0)" ::: "memory");
          BAR_ALL(); }
    }
    SEG_S(NT - 1);
    { const int cp = (ci == 0) ? 2 : ci - 1; SEG_M(false, true, 0, cp); BAR_ALL(); }
#undef SEG_S
#undef SEG_M
    if (ATT_SKEW && g == 0) BAR_ALL();
    if (hi == 0) li_l[r32] = l_reg; asm volatile("s_waitcnt lgkmcnt(0)" ::: "memory");
#pragma unroll
    for (int r = 0; r < 16; ++r) rli[r] = XP ? 0.f : __builtin_amdgcn_rcpf(li_l[crow(r, hi)]);
    asm volatile("s_waitcnt vmcnt(0) lgkmcnt(0)" ::: "memory");
    BAR_ALL();
#undef DMA_K
#undef DMA_V
}
#undef LW2
#undef LW8
#undef BAR_ALL
#undef SBAR
}

#ifndef PH_MASK
#define PH_MASK 0x3ff
#endif
#define PH(k) (((PH_MASK) >> (k)) & 1)
#ifndef PH_ATT
#define PH_ATT 3
#endif
#ifndef REP_MASK
#define REP_MASK 0x000
#endif
#define NREP(k) ((((REP_MASK) >> (k)) & 1) ? 2 : 1)
#ifndef ATT_X
#define ATT_X 0
#endif
#ifndef REP_P6
#define REP_P6 1
#endif
#ifndef REP_MLA
#define REP_MLA 1
#endif
#ifndef REP_DIFF
#define REP_DIFF 1
#endif
struct Args { const float* in[25]; float* out; unsigned char* ws; };

__device__ __forceinline__ void cvt_item(const float* W, int N, int scol, const float* kscale, int k0, bf16_t* WT, int K, int drow0, LAS float* scr, int lane) {
#pragma unroll 16
    for (int i = 0; i < 32; ++i) { const int kk = 2 * i + (lane >> 5); float v = 0.f;
        if (scol >= 0) { v = W[(size_t)(k0 + kk) * N + scol]; if (kscale) v *= kscale[k0 + kk]; }
        scr[kk * 33 + (lane & 31)] = v; }
    LDS_WAIT(); asm volatile("" ::: "memory");
    const int c = lane & 7;
#pragma unroll
    for (int j = 0; j < 4; ++j) { const int n = (lane >> 3) + 8 * j; const LAS float* s = scr + (8 * c) * 33 + n;
        u32x4 o; o.x = pk2(s[0 * 33], s[1 * 33]); o.y = pk2(s[2 * 33], s[3 * 33]); o.z = pk2(s[4 * 33], s[5 * 33]); o.w = pk2(s[6 * 33], s[7 * 33]);
        *(GAS u32x4*)(WT + (size_t)(drow0 + n) * K + k0 + 8 * c) = o; }
    LDS_WAIT(); asm volatile("" ::: "memory");
}
__device__ __forceinline__ int il64(int w) { return (w >> 1) + 32 * (w & 1); }

__global__ void __launch_bounds__(512, 2) hymba_fwd(Args args) {
    extern __shared__ __attribute__((aligned(16))) unsigned char lds[];
    LAS unsigned char* ldsL = (LAS unsigned char*)lds;
    volatile LAS unsigned* MISC = (volatile LAS unsigned*)(ldsL + MISC_OFF);
    const int wave = __builtin_amdgcn_readfirstlane((int)threadIdx.x >> 6);
    const int G = gridDim.x; const int bx = blockIdx.x; const int vcu = (G % 8 == 0) ? (bx % 8) * (G / 8) + bx / 8 : bx;
#define CAS __attribute__((address_space(4)))
#define LOAD_ARGP() const CAS Args* argp = (const CAS Args*)__builtin_amdgcn_kernarg_segment_ptr(); asm volatile("" : "+s"(argp)); unsigned char* const ws = argp->ws; (void)ws
    unsigned* ctl; { LOAD_ARGP(); ctl = (unsigned*)(ws + WS_CTL); }
    { const int t0 = wave * 64 + lane_id_v(); if (t0 < 128) MISC[t0] = 0u; }
    __syncthreads();
    const XcdBarrier bar = xcd_barrier_post(ctl + CW_BAR, MISC + 8, wave);

#define MODP ((float*)(ws + WS_MODP))
#define MOD ((float*)(ws + WS_MOD))
#define MISCW ((float*)(ws + WS_MISC))
#define ROPE ((float*)(ws + WS_ROPE))
#define SSQQ ((float*)(ws + WS_SSQQ))
#define SSQKV ((float*)(ws + WS_SSQKV))
#define WIN ((bf16_t*)(ws + WS_WIN))
#define WQ ((bf16_t*)(ws + WS_WQ))
#define WKV ((bf16_t*)(ws + WS_WKV))
#define WOUT ((bf16_t*)(ws + WS_WOUT))
#define WR ((float*)(ws + WS_WR))
#define WGU ((bf16_t*)(ws + WS_WGU))
#define WDN ((bf16_t*)(ws + WS_WDN))
#define LIST ((int*)(ws + WS_LIST))
#define LISTW ((float*)(ws + WS_LISTW))
#define HB ((bf16_t*)(ws + WS_H))
#define CQ ((bf16_t*)(ws + WS_CQ))
#define CKV ((bf16_t*)(ws + WS_CKV))
#define QA ((bf16_t*)(ws + WS_QA))
#define KA ((bf16_t*)(ws + WS_KA))
#define VA ((bf16_t*)(ws + WS_VA))
#define DQ ((bf16_t*)(ws + WS_DQ))
#define DK ((bf16_t*)(ws + WS_DK))
#define DVb ((bf16_t*)(ws + WS_DV))
#define ATT ((bf16_t*)(ws + WS_ATT))
#define ACT ((bf16_t*)(ws + WS_ACT))
#define YB ((bf16_t*)(ws + WS_Y))
#define STASH ((float*)(ws + WS_STASH))
#define XIN (argp->in[0])
#define XOUT (argp->out)
    unsigned* ECNT = ctl + CW_ECNT;
    const int gw = vcu * 8 + wave, NGW = G * 8;

    _Pragma("unroll") for (int rep_ = 0; rep_ < NREP(0); ++rep_)
    if (PH(0)) {
        const int lane = lane_id_v(), tid = wave * 64 + lane; (void)tid;
        LOAD_ARGP();
        LAS float* scr = (LAS float*)(ldsL + wave * 16384);
        constexpr int I_IN = 16 * (IN_PAD / 32), I_Q = 4 * 24, I_KV = 4 * 32, I_OUT = 16 * 32, I_GU = 16 * 32, I_DN = 8 * 32;
        constexpr int NITEMS = I_IN + I_Q + I_KV + I_OUT + NEXP * (I_GU + I_DN);
        for (int it = gw; it < NITEMS; it += NGW) {
            int r = it; const int l31 = lane & 31;
            if (r < I_IN) { const int nblk = IN_PAD / 32, kb = r / nblk, nb = r % nblk, n = nb * 32 + l31; int sc;
                if (n < 512) sc = n; else if (n < 1536) { const int m = n - 512; sc = 576 + (m & ~63) + il64(m & 63); } else if (n < 2048) sc = 1600 + (n - 1536); else if (n < 2112) sc = 512 + il64(n - 2048); else sc = -1;
                cvt_item(argp->in[5], 2112, sc, nullptr, kb * 64, WIN, 1024, nb * 32, scr, lane); continue; }
            r -= I_IN;
            if (r < I_Q) { const int nblk = 24, kb = r / nblk, nb = r % nblk, n = nb * 32 + l31; const int hd = n / 192, w = n % 192; const int sc = (w < 128) ? n : hd * 192 + 128 + il64(w - 128);
                cvt_item(argp->in[7], 768, sc, argp->in[6], kb * 64, WQ, 256, nb * 32, scr, lane); continue; }
            r -= I_Q;
            if (r < I_KV) { const int nblk = 32, kb = r / nblk, nb = r % nblk;
                cvt_item(argp->in[9], 1024, nb * 32 + l31, argp->in[8], kb * 64, WKV, 256, nb * 32, scr, lane); continue; }
            r -= I_KV;
            if (r < I_OUT) { const int nblk = 32, kb = r / nblk, nb = r % nblk;
                cvt_item(argp->in[15], 1024, nb * 32 + l31, nullptr, kb * 64, WOUT, 1024, nb * 32, scr, lane); continue; }
            r -= I_OUT;
            { const int e = r / (I_GU + I_DN); int q = r % (I_GU + I_DN);
              if (q < I_GU) { const int nblk = 32, kb = q / nblk, nb = q % nblk; const int n0 = nb * 32, pn = n0 >> 8, rr = n0 & 255, bj = rr >> 7, c = rr & 127;
                  const float* src = (bj ? argp->in[22] : argp->in[21]) + (size_t)e * 1024 * 512;
                  cvt_item(src, 512, pn * 128 + c + l31, nullptr, kb * 64, WGU + (size_t)e * 1024 * 1024, 1024, n0, scr, lane); }
              else { q -= I_GU; const int nblk = 32, kb = q / nblk, nb = q % nblk;
                  cvt_item(argp->in[23] + (size_t)e * 512 * 1024, 1024, nb * 32 + l31, nullptr, kb * 64, WDN + (size_t)e * 1024 * 512, 512, nb * 32, scr, lane); } }
        }
        for (int i = bx * 512 + tid; i < 36 * 1024; i += G * 512) { const int j = i >> 10, k = i & 1023;
            WR[i] = (j < 4) ? argp->in[17][k * 4 + j] : argp->in[19][k * 32 + (j - 4)]; }
        for (int i = bx * 512 + tid; i < SEQ * 32; i += G * 512) { const int pos = i >> 5, fi = i & 31;
            const float inv = (float)pow(10000.0, -(double)(2 * fi) / 64.0); const float ang = (float)pos * inv;
            ROPE[2 * i] = (float)cos((double)ang); ROPE[2 * i + 1] = (float)sin((double)ang); }
        for (int it = gw; it < 96 * 8; it += NGW) { const int ng = it % 96, kc = it / 96; const float* cin = argp->in[1];
#pragma unroll
            for (int i = 0; i < 16; ++i) { const int idx = i * 64 + lane, kk = idx >> 3, b = idx & 7; const float cv = cin[b * 1024 + kc * 128 + kk]; scr[idx] = cv / (1.0f + expf(-cv)); }
            LDS_WAIT(); asm volatile("" ::: "memory");
            float a[8] = {0.f, 0.f, 0.f, 0.f, 0.f, 0.f, 0.f, 0.f}; const float* wp = argp->in[2] + (size_t)(kc * 128) * 6144 + ng * 64 + lane;
#pragma unroll 8
            for (int kk = 0; kk < 128; ++kk) { const float w = wp[(size_t)kk * 6144]; const LAS f32x4* sp = (const LAS f32x4*)(scr + kk * 8); const f32x4 s0 = sp[0], s1 = sp[1];
                a[0] += s0[0] * w; a[1] += s0[1] * w; a[2] += s0[2] * w; a[3] += s0[3] * w; a[4] += s1[0] * w; a[5] += s1[1] * w; a[6] += s1[2] * w; a[7] += s1[3] * w; }
#pragma unroll
            for (int b = 0; b < 8; ++b) MODP[((size_t)kc * 8 + b) * 6144 + ng * 64 + lane] = a[b];
            LDS_WAIT(); asm volatile("" ::: "memory");
        }
        if (bx == 0 && wave == 0) { const float a = wave_sum(argp->in[10][lane] * argp->in[11][lane]), b = wave_sum(argp->in[12][lane] * argp->in[13][lane]);
            if (lane == 0) MISCW[0] = expf(a) - expf(b) + 0.2f; }
    }
    xcd_barrier(bar, wave); if (BAR_DBL) xcd_barrier(bar, wave);

    _Pragma("unroll") for (int rep_ = 0; rep_ < NREP(1); ++rep_)
    if (PH(1)) {
        const int lane = lane_id_v(), tid = wave * 64 + lane; (void)tid;
        LOAD_ARGP();
        for (int i = bx * 512 + tid; i < 8 * 6144; i += G * 512) { float s = argp->in[3][i % 6144];
#pragma unroll
            for (int kc = 0; kc < 8; ++kc) s += MODP[(size_t)kc * 8 * 6144 + i];
            MOD[i] = s; }
        for (int p = vcu; p < NPANEL; p += G) { const int b = p >> 5;
            f32x4 av[4], sv[4];
#pragma unroll
            for (int j = 0; j < 4; ++j) { const int c0 = 4 * lane + 256 * j;
#pragma unroll
                for (int q = 0; q < 4; ++q) { float sh = argp->in[3][c0 + q], scl = argp->in[3][1024 + c0 + q];
#pragma unroll
                    for (int kc = 0; kc < 8; ++kc) { sh += MODP[((size_t)kc * 8 + b) * 6144 + c0 + q]; scl += MODP[((size_t)kc * 8 + b) * 6144 + 1024 + c0 + q]; }
                    av[j][q] = argp->in[4][c0 + q] * (1.0f + scl); sv[j][q] = sh; } }
            for (int rr = 0; rr < 32; ++rr) { const size_t row = (size_t)p * 256 + wave * 32 + rr;
                const GAS f32x4* xr = (const GAS f32x4*)(XIN + row * DM) + lane; f32x4 v[4]; float s = 0.f;
#pragma unroll
                for (int j = 0; j < 4; ++j) { v[j] = xr[64 * j]; s += (v[j][0] * v[j][0] + v[j][1] * v[j][1]) + (v[j][2] * v[j][2] + v[j][3] * v[j][3]); }
                const float rstd = 1.0f / sqrtf(wave_sum(s) * (1.0f / DM) + EPS);
                GAS u32x2* o8 = (GAS u32x2*)(HB + row * DM) + lane;
#pragma unroll
                for (int j = 0; j < 4; ++j) { const f32x4 h = v[j] * rstd * av[j] + sv[j]; u32x2 w; w.x = pk2(h[0], h[1]); w.y = pk2(h[2], h[3]); o8[64 * j] = w; } }
        }
    }
    xcd_barrier(bar, wave); if (BAR_DBL) xcd_barrier(bar, wave);

    _Pragma("unroll") for (int rep_ = 0; rep_ < NREP(2); ++rep_)
    if (PH(2)) {
        const int lane = lane_id_v(), tid = wave * 64 + lane; (void)tid;
        LOAD_ARGP();
        pg8::StaticOrder S; S.init(T_TOK, IN_PAD, G, bx);
        pg8::EpiG1 E{CQ, CKV, DQ, DK, DVb, KA, SSQQ, SSQKV, ROPE};
        pg8::gemm_phase<pg8::EpiG1, pg8::StaticOrder, false>(ldsL, wave, HB, DM, WIN, DM, 0, DM, S, E);
    }
    xcd_barrier(bar, wave); if (BAR_DBL) xcd_barrier(bar, wave);

    _Pragma("unroll") for (int rep_ = 0; rep_ < NREP(3); ++rep_)
    if (PH(3)) {
        const int lane = lane_id_v(), tid = wave * 64 + lane; (void)tid;
        LOAD_ARGP();
        { pg8::StaticOrder S; S.init(T_TOK, 768, G, bx); pg8::EpiQ E{QA, SSQQ, ROPE};
          pg8::gemm_phase<pg8::EpiQ, pg8::StaticOrder, false>(ldsL, wave, CQ, 256, WQ, 256, 0, 256, S, E); }
        { pg8::StaticOrder S; S.init(T_TOK, 1024, G, bx); pg8::EpiKV E{KA, VA, SSQKV};
          pg8::gemm_phase<pg8::EpiKV, pg8::StaticOrder, false>(ldsL, wave, CKV, 256, WKV, 256, 0, 256, S, E); }
    }
    xcd_barrier(bar, wave); if (BAR_DBL) xcd_barrier(bar, wave);

    if (PH(4)) {
        const int lane = lane_id_v(), tid = wave * 64 + lane; (void)tid;
        LOAD_ARGP();
        const int r32 = lane & 31, hi = lane >> 5;
        const float lam = MISCW[0];
#if PH_ATT & 1
#if ATT_X
        for (int u = vcu; u < 1024; u += G) {
            const int bhi = u >> 5, qb = u & 31;
            f32x16 o[4]; float rli[16];
            const int b = bhi >> 2, h = bhi & 3; const size_t tok0 = (size_t)b * SEQ;
            att::attn_core2<192, 768, 768, 512, ATT_X>(QA + (tok0 + qb * 256) * 768 + h * 192, KA + tok0 * 768 + h * 192, VA + tok0 * 512 + h * 128, (char*)lds, wave, o, rli);
            GAS bf16_t* Ow = (GAS bf16_t*)(ATT + (tok0 + qb * 256 + wave * 32 + 4 * hi) * DM + h * 128 + r32);
            asm volatile("" : "+v"(Ow));
#pragma unroll
            for (int r = 0; r < 16; ++r) {
#pragma unroll
                for (int d0 = 0; d0 < 4; ++d0) Ow[(size_t)((r & 3) + 8 * (r >> 2)) * DM + d0 * 32] = (bf16_t)f2bf(o[d0][r] * rli[r]); }
        }
#endif
        for (int rep = 0; rep < REP_MLA; ++rep)
        for (int u = vcu; u < 1024; u += G) {
            const int bhi = u >> 5, qb = u & 31;
            f32x16 o[4]; float rli[16];
            const int b = bhi >> 2, h = bhi & 3; const size_t tok0 = (size_t)b * SEQ;
            att::attn_core2<192, 768, 768, 512>(QA + (tok0 + qb * 256) * 768 + h * 192, KA + tok0 * 768 + h * 192, VA + tok0 * 512 + h * 128, (char*)lds, wave, o, rli);
            GAS bf16_t* Ow = (GAS bf16_t*)(ATT + (tok0 + qb * 256 + wave * 32 + 4 * hi) * DM + h * 128 + r32);
            asm volatile("" : "+v"(Ow));
#pragma unroll
            for (int r = 0; r < 16; ++r) {
#pragma unroll
                for (int d0 = 0; d0 < 4; ++d0) Ow[(size_t)((r & 3) + 8 * (r >> 2)) * DM + d0 * 32] = (bf16_t)f2bf(o[d0][r] * rli[r]); }
        }
#endif
#if PH_ATT & 2
        for (int rep = 0; rep < REP_DIFF; ++rep)
        for (int it = 0;; ++it) {
            const int u = vcu + (it >> 1) * G, j = it & 1;
            if (u >= 1024) break;
            const int bh = u >> 5, qb = u & 31, b = bh >> 2, h = bh & 3; const size_t tok0 = (size_t)b * SEQ;
            f32x16 o[4]; float rli[16];
            GAS float* st = (GAS float*)(STASH + ((size_t)bx * 8 + wave) * 4096 + lane);
            att::attn_core2<64, 512, 512, 512, 0, DIFF_DMA_M>(DQ + (tok0 + qb * 256) * 512 + h * 128 + j * 64, DK + tok0 * 512 + h * 128 + j * 64, DVb + tok0 * 512 + h * 128, (char*)lds, wave, o, rli);
            asm volatile("" : "+v"(st));
            if (j == 0) {
#pragma unroll
                for (int d0 = 0; d0 < 4; ++d0)
#pragma unroll
                    for (int r = 0; r < 16; ++r) st[(d0 * 16 + r) * 64] = o[d0][r] * rli[r];
                VM_WAIT();
            } else {
                float gsub[4];
#pragma unroll
                for (int d0 = 0; d0 < 4; ++d0) gsub[d0] = argp->in[14][d0 * 32 + r32] * 0.8f;
                GAS bf16_t* Ow = (GAS bf16_t*)(ATT + (tok0 + qb * 256 + wave * 32 + 4 * hi) * DM + 512 + h * 128 + r32);
                asm volatile("" : "+v"(Ow));
#pragma unroll
                for (int r = 0; r < 16; ++r) { float v[4]; float s = 0.f;
                    if ((r & 3) == 0) asm volatile("" ::: "memory");
#pragma unroll
                    for (int d0 = 0; d0 < 4; ++d0) { v[d0] = __hip_atomic_load(st + (d0 * 16 + r) * 64, RLX_AGENT) - lam * (o[d0][r] * rli[r]); s += v[d0] * v[d0]; }
#pragma unroll
                    for (int of = 1; of < 32; of <<= 1) s += __shfl_xor(s, of);
                    const float rstd = 1.0f / sqrtf(s * (1.0f / 128.0f) + EPS);
#pragma unroll
                    for (int d0 = 0; d0 < 4; ++d0) Ow[(size_t)((r & 3) + 8 * (r >> 2)) * DM + d0 * 32] = (bf16_t)f2bf(v[d0] * rstd * gsub[d0]); }
                VM_WAIT();
            }
        }
#endif
    }
    xcd_barrier(bar, wave); if (BAR_DBL) xcd_barrier(bar, wave);

    _Pragma("unroll") for (int rep_ = 0; rep_ < NREP(5); ++rep_)
    if (PH(5)) {
        const int lane = lane_id_v(), tid = wave * 64 + lane; (void)tid;
        LOAD_ARGP();
        pg8::StaticOrder S; S.init(T_TOK, DM, G, bx);
        pg8::EpiX1 E{XIN, XOUT, MOD};
        pg8::gemm_phase<pg8::EpiX1, pg8::StaticOrder, false>(ldsL, wave, ATT, DM, WOUT, DM, 0, DM, S, E);
    }
    xcd_barrier(bar, wave); if (BAR_DBL) xcd_barrier(bar, wave);

    if (PH(6)) {
        LOAD_ARGP();
        LAS f32x4* WE4 = (LAS f32x4*)ldsL;
        LAS f32x4* WG4 = (LAS f32x4*)(ldsL + 131072);
        LAS int* selE = (LAS int*)(ldsL + 147456);
        LAS float* selW = (LAS float*)(ldsL + 147456 + 2048);
        LAS int* selP = (LAS int*)(ldsL + 147456 + 4096);
        LAS int* lcnt = (LAS int*)(ldsL + 147456 + 6144);
        LAS int* lbase = (LAS int*)(ldsL + 147456 + 6144 + 128);
        LAS float* biasL = (LAS float*)(ldsL + 147456 + 6144 + 256);
        const float* Wg = argp->in[17]; const float* We = argp->in[19];
        for (int p = vcu; p < NPANEL; p += G) { const int b = p >> 5;
            const int lane = lane_id_v(), tid = wave * 64 + lane;
            const float* scl2 = MOD + (size_t)(b * 6 + 4) * DM; const float* sh2 = MOD + (size_t)(b * 6 + 3) * DM; const float* g2p = argp->in[16];
            if (tid < 32) lcnt[tid] = 0;
            for (int i = tid; i < 1024 * 32; i += 512) { const int k = i >> 5, n = i & 31; const float a2 = g2p[k] * (1.0f + scl2[k]);
                ((LAS float*)WE4)[(((k >> 3) * 2 + ((k >> 2) & 1)) * 32 + n) * 4 + (k & 3)] = a2 * We[i]; }
            for (int i = tid; i < 1024 * 4; i += 512) { const int k = i >> 2; const float a2 = g2p[k] * (1.0f + scl2[k]); ((LAS float*)WG4)[i] = a2 * Wg[i]; }
            for (int n = wave; n < 36; n += 8) { float a = 0.f;
#pragma unroll
                for (int q = 0; q < 16; ++q) { const int k = lane + 64 * q; a += sh2[k] * ((n < 4) ? Wg[k * 4 + n] : We[k * 32 + (n - 4)]); }
                a = wave_sum(a); if (lane == 0) biasL[n] = a + ((n < 4) ? argp->in[18][n] : argp->in[20][n - 4]); }
            __syncthreads();
            int lane1 = lane; asm volatile("" : "+v"(lane1));
            const int r32 = lane1 & 31, khalf = lane1 >> 5; const int rl = wave * 32 + r32; const size_t row = (size_t)p * 256 + rl;
            const GAS f32x4* xp = (const GAS f32x4*)(XOUT + row * DM) + khalf;
            f32x16 acc = f32x16{}; float gl0 = 0.f, gl1 = 0.f, gl2 = 0.f, gl3 = 0.f, ssq = 0.f;
#define P6_STEP(X, m) do { const f32x4 W = WE4[(m) * 64 + lane1]; const LAS f32x4* gp = WG4 + ((m) * 2 + khalf) * 4; const f32x4 G0 = gp[0], G1 = gp[1], G2 = gp[2], G3 = gp[3];                \
                acc = __builtin_amdgcn_mfma_f32_32x32x2f32(W[0], X[0], acc, 0, 0, 0); acc = __builtin_amdgcn_mfma_f32_32x32x2f32(W[1], X[1], acc, 0, 0, 0);                                        \
                acc = __builtin_amdgcn_mfma_f32_32x32x2f32(W[2], X[2], acc, 0, 0, 0); acc = __builtin_amdgcn_mfma_f32_32x32x2f32(W[3], X[3], acc, 0, 0, 0);                                        \
                gl0 += X[0] * G0[0] + X[1] * G1[0] + X[2] * G2[0] + X[3] * G3[0]; gl1 += X[0] * G0[1] + X[1] * G1[1] + X[2] * G2[1] + X[3] * G3[1];                                                \
                gl2 += X[0] * G0[2] + X[1] * G1[2] + X[2] * G2[2] + X[3] * G3[2]; gl3 += X[0] * G0[3] + X[1] * G1[3] + X[2] * G2[3] + X[3] * G3[3];                                                \
                ssq += (X[0] * X[0] + X[1] * X[1]) + (X[2] * X[2] + X[3] * X[3]); if ((m) & 1) asm volatile("" ::: "memory"); } while (0)
            f32x4 Xa[4], Xb[4];
#pragma unroll
            for (int q = 0; q < 4; ++q) Xa[q] = xp[2 * q];
#pragma nounroll
            for (int mg = 0; mg < 128; mg += 8) {
                const int mn = (mg + 8 < 128) ? mg + 8 : 120;
#pragma unroll
                for (int q = 0; q < 4; ++q) Xb[q] = xp[2 * (mg + 4 + q)];
#pragma unroll
                for (int q = 0; q < 4; ++q) P6_STEP(Xa[q], mg + q);
#pragma unroll
                for (int q = 0; q < 4; ++q) Xa[q] = xp[2 * (mn + q)];
#pragma unroll
                for (int q = 0; q < 4; ++q) P6_STEP(Xb[q], mg + 4 + q);
            }
#undef P6_STEP
#define XSUM(v) do { auto rr_ = __builtin_amdgcn_permlane32_swap(__float_as_uint(v), __float_as_uint(v), false, false); v = __uint_as_float(rr_[0]) + __uint_as_float(rr_[1]); } while (0)
            XSUM(ssq); XSUM(gl0); XSUM(gl1); XSUM(gl2); XSUM(gl3);
#undef XSUM
            const float rstd = 1.0f / sqrtf(ssq * (1.0f / DM) + EPS);
            { float lg0 = rstd * gl0 + biasL[0], lg1 = rstd * gl1 + biasL[1], lg2 = rstd * gl2 + biasL[2], lg3 = rstd * gl3 + biasL[3];
              int gi = 0; float gm = lg0; if (lg1 > gm) { gm = lg1; gi = 1; } if (lg2 > gm) { gm = lg2; gi = 2; } if (lg3 > gm) { gm = lg3; gi = 3; }
              const float gprob = 1.0f / (expf(lg0 - gm) + expf(lg1 - gm) + expf(lg2 - gm) + expf(lg3 - gm));
              float mine[4], oth[4];
#pragma unroll
              for (int q = 0; q < 4; ++q) { const float c = (gi == 0) ? acc[q] : (gi == 1) ? acc[4 + q] : (gi == 2) ? acc[8 + q] : acc[12 + q];
                  mine[q] = rstd * c + biasL[4 + gi * 8 + khalf * 4 + q];
                  auto rr_ = __builtin_amdgcn_permlane32_swap(__float_as_uint(mine[q]), __float_as_uint(mine[q]), false, false);
                  oth[q] = khalf ? __uint_as_float(rr_[0]) : __uint_as_float(rr_[1]); }
              float es[8];
#pragma unroll
              for (int j = 0; j < 8; ++j) es[j] = ((j >> 2) == khalf) ? mine[j & 3] : oth[j & 3];
              int i0 = 0; float l0 = es[0];
#pragma unroll
              for (int j = 1; j < 8; ++j) if (es[j] > l0) { l0 = es[j]; i0 = j; }
              int i1 = -1; float l1 = -3.0e38f;
#pragma unroll
              for (int j = 0; j < 8; ++j) if (j != i0 && (i1 < 0 || es[j] > l1)) { l1 = es[j]; i1 = j; }
              const float ex = expf(l1 - l0); const float w0 = gprob / (1.0f + ex), w1 = gprob * ex / (1.0f + ex);
              if (khalf == 0) { const int e0 = gi * 8 + i0, e1 = gi * 8 + i1;
                  selE[rl * 2] = e0; selE[rl * 2 + 1] = e1; selW[rl * 2] = w0; selW[rl * 2 + 1] = w1;
                  selP[rl * 2] = __hip_atomic_fetch_add(lcnt + e0, 1, __ATOMIC_RELAXED, __HIP_MEMORY_SCOPE_WORKGROUP);
                  selP[rl * 2 + 1] = __hip_atomic_fetch_add(lcnt + e1, 1, __ATOMIC_RELAXED, __HIP_MEMORY_SCOPE_WORKGROUP); } }
            { f32x4 av[4], sv[4]; int lane2 = lane; asm volatile("" : "+v"(lane2));
#pragma unroll
              for (int j = 0; j < 4; ++j) { const int c0 = 4 * lane2 + 256 * j; sv[j] = *(const f32x4*)(sh2 + c0); av[j] = *(const f32x4*)(g2p + c0) * (1.0f + *(const f32x4*)(scl2 + c0)); }
              for (int rr = 0; rr < 32; ++rr) { const size_t row2 = (size_t)p * 256 + wave * 32 + rr; const float rs = __int_as_float(__builtin_amdgcn_readlane(__float_as_int(rstd), rr));
                  const GAS f32x4* xr = (const GAS f32x4*)(XOUT + row2 * DM) + lane2; GAS u32x2* o8 = (GAS u32x2*)(HB + row2 * DM) + lane2;
#pragma unroll
                  for (int j = 0; j < 4; ++j) { const f32x4 h = xr[64 * j] * rs * av[j] + sv[j]; u32x2 w; w.x = pk2(h[0], h[1]); w.y = pk2(h[2], h[3]); o8[64 * j] = w; } } }
            __syncthreads();
            const int tidB = wave * 64 + lane_id_v();
            if (tidB < 32) lbase[tidB] = (int)__hip_atomic_fetch_add(ECNT + tidB, (unsigned)lcnt[tidB], RLX_AGENT);
            __syncthreads();
            { const int tid = tidB; const int rl = tid >> 1, k = tid & 1; const int e = selE[tid]; const int pos = lbase[e] + selP[tid];
              LIST[e * LCAP + pos] = ((p * 256 + rl) << 1) | k; LISTW[e * LCAP + pos] = selW[tid]; }
            __syncthreads();
        }
    }
    xcd_barrier(bar, wave); if (BAR_DBL) xcd_barrier(bar, wave);

    _Pragma("unroll") for (int rep_ = 0; rep_ < NREP(7); ++rep_)
    if (PH(7)) {
        const int lane = lane_id_v(), tid = wave * 64 + lane; (void)tid;
        LOAD_ARGP();
        pg8::MoeOrder S; S.init(ECNT, LIST, G, vcu);
        pg8::EpiAct E{ACT};
        pg8::gemm_phase<pg8::EpiAct, pg8::MoeOrder, true>(ldsL, wave, HB, DM, WGU, DM, (size_t)1024 * 1024, DM, S, E);
    }
    xcd_barrier(bar, wave); if (BAR_DBL) xcd_barrier(bar, wave);

    _Pragma("unroll") for (int rep_ = 0; rep_ < NREP(8); ++rep_)
    if (PH(8)) {
        const int lane = lane_id_v(), tid = wave * 64 + lane; (void)tid;
        LOAD_ARGP();
        pg8::MoeOrder S; S.init(ECNT, LIST, G, vcu);
        pg8::EpiDown E{YB, LIST, LISTW};
        pg8::gemm_phase<pg8::EpiDown, pg8::MoeOrder, false>(ldsL, wave, ACT, DEXP, WDN, DEXP, (size_t)1024 * 512, DEXP, S, E);
    }
    xcd_barrier(bar, wave); if (BAR_DBL) xcd_barrier(bar, wave);

    if (PH(9)) {
        const int lane = lane_id_v(), tid = wave * 64 + lane; (void)tid;
        LOAD_ARGP();
        const bool bad = xb_ld(ctl + CW_BAR + XB_TMO) != 0u;
        for (int p = vcu; p < NPANEL; p += G) { const int b = p >> 5;
            f32x4 gv[4], fv[4];
#pragma unroll
            for (int j = 0; j < 4; ++j) { const int c0 = 4 * lane + 256 * j; gv[j] = *(const f32x4*)(MOD + (size_t)(b * 6 + 5) * DM + c0); fv[j] = *(const f32x4*)(argp->in[24] + c0); }
            for (int rr = 0; rr < 32; ++rr) { const size_t row = (size_t)p * 256 + wave * 32 + rr;
                GAS f32x4* xr = (GAS f32x4*)(XOUT + row * DM) + lane; const GAS u32x2* y0 = (const GAS u32x2*)(YB + (row * 2) * DM) + lane; const GAS u32x2* y1 = (const GAS u32x2*)(YB + (row * 2 + 1) * DM) + lane;
                f32x4 v[4]; float s = 0.f;
#pragma unroll
                for (int j = 0; j < 4; ++j) { const f32x4 xv = xr[64 * j]; const u32x2 a = y0[64 * j], c = y1[64 * j];
                    f32x4 ys; ys[0] = bf_lo(a.x) + bf_lo(c.x); ys[1] = bf_hi(a.x) + bf_hi(c.x); ys[2] = bf_lo(a.y) + bf_lo(c.y); ys[3] = bf_hi(a.y) + bf_hi(c.y);
                    v[j] = xv + gv[j] * ys; s += (v[j][0] * v[j][0] + v[j][1] * v[j][1]) + (v[j][2] * v[j][2] + v[j][3] * v[j][3]); }
                const float rstd = 1.0f / sqrtf(wave_sum(s) * (1.0f / DM) + EPS);
#pragma unroll
                for (int j = 0; j < 4; ++j) { f32x4 o = v[j] * rstd * fv[j]; if (bad) o = (f32x4){__builtin_nanf(""), __builtin_nanf(""), __builtin_nanf(""), __builtin_nanf("")}; xr[64 * j] = o; } }
        }
    }
}
#undef MODP
#undef MOD
#undef MISCW
#undef ROPE
#undef SSQQ
#undef SSQKV
#undef WIN
#undef WQ
#undef WKV
#undef WOUT
#undef WR
#undef WGU
#undef WDN
#undef LIST
#undef LISTW
#undef HB
#undef CQ
#undef CKV
#undef QA
#undef KA
#undef VA
#undef DQ
#undef DK
#undef DVb
#undef ATT
#undef ACT
#undef YB
#undef STASH
#undef XIN
#undef XOUT
#undef CAS
#undef LOAD_ARGP

extern "C" void kernel_launch(void* const* d_in, const int* in_sizes, int n_in, void* d_out, int out_size, void* d_ws, size_t ws_size, hipStream_t stream) {
    static int grid = 0;
    if (grid == 0) {
        if (n_in != 25 || in_sizes[0] != T_TOK * DM || out_size != T_TOK * DM || ws_size < WS_END) {
            fprintf(stderr, "kernel_launch: shape mismatch (n_in %d, in0 %d, out %d, ws %zu, need %zu)\n", n_in, n_in > 0 ? in_sizes[0] : -1, out_size, ws_size, (size_t)WS_END); grid = -1; return; }
        int dev = 0, cus = 0, per_cu = 0;
        if (hipGetDevice(&dev) != hipSuccess || hipDeviceGetAttribute(&cus, hipDeviceAttributeMultiprocessorCount, dev) != hipSuccess) { grid = -1; return; }
        if (hipFuncSetAttribute((const void*)hymba_fwd, hipFuncAttributeMaxDynamicSharedMemorySize, LDS_BYTES) != hipSuccess) { fprintf(stderr, "kernel_launch: hipFuncSetAttribute failed\n"); grid = -1; return; }
        if (hipOccupancyMaxActiveBlocksPerMultiprocessor(&per_cu, (const void*)hymba_fwd, 512, LDS_BYTES) != hipSuccess || per_cu < 1)
            fprintf(stderr, "kernel_launch: note: occupancy query reports %d\n", per_cu);
        (void)hipGetLastError();
        grid = cus;
    }
    if (grid < 0) return;
    if (hipMemsetAsync((char*)d_ws + WS_CTL, 0, CTL_ZERO_BYTES, stream) != hipSuccess) return;
    Args a{};
    for (int i = 0; i < 25; ++i) a.in[i] = (const float*)d_in[i];
    a.out = (float*)d_out; a.ws = (unsigned char*)d_ws;
    hipLaunchKernelGGL(hymba_fwd, dim3(grid), dim3(512), LDS_BYTES, stream, a);
    const hipError_t le = hipPeekAtLastError();
    if (le != hipSuccess) fprintf(stderr, "kernel_launch: launch failed: %s\n", hipGetErrorName(le));
}
```
